# Optimizing an MI355X kernel written in HIP

```python
import jax
import jax.numpy as jnp
from jax import lax
import numpy as np

D_MODEL = 1024
BATCH = 8
SEQ = 4096
DEPTH = 2

MEM_LEN = 256
HEAD_DIM = 64
NEG_INF = -1e30
FORCE_SCORE = 1e6
LN_EPS = 1e-5
DN_ALPHA = (2.0 * DEPTH) ** 0.25
DN_BETA = (8.0 * DEPTH) ** -0.25

MIX_WIDTH = 512

NSA_HEADS = 8
NSA_KV_HEADS = 2
NSA_GROUP = NSA_HEADS // NSA_KV_HEADS
NSA_WIDTH = NSA_HEADS * HEAD_DIM
CMP_BLOCK = 32
CMP_STRIDE = 16
CMP_HIDDEN = 256
SLC_BLOCK = 64
SLC_TOPK = 16
WINDOW = 512
SLC_QCHUNK = 64
WIN_QCHUNK = 128

MOBA_HEADS = 8
MOBA_WIDTH = MOBA_HEADS * HEAD_DIM
MOBA_BLOCK = 256
MOBA_TOPK = 3
MOBA_QCHUNK = 32

CONV_CH = MIX_WIDTH
CONV_K = 3

N_BRANCH = 3
NSA_KV_COLS = 6 * NSA_KV_HEADS * HEAD_DIM
NSA_GATE_COLS = 3 * NSA_HEADS
MOBA_COLS = 3 * MOBA_WIDTH
CONV_COLS = 3 * CONV_CH
MERGE_COLS = N_BRANCH * D_MODEL
N_IN = NSA_WIDTH + NSA_KV_COLS + NSA_GATE_COLS + MOBA_COLS + CONV_COLS + MERGE_COLS

XATTN_HEADS = 4
XATTN_HEAD_DIM = 128
XATTN_WIDTH = XATTN_HEADS * XATTN_HEAD_DIM

N_EXPERTS = 256
TOP_K = 8
N_GROUPS = 8
TOPK_GROUPS = 4
EXPERT_DIM = 256
SHARED_DIM = 256
ROUTE_SCALE = 2.5
MOE_BLOCK = 128

kernel_name = 'hybrid_nsa_moba_shortconv_moe'


def layer_norm(x, g, b):
    xf = x.astype(jnp.float32)
    mu = jnp.mean(xf, axis=-1, keepdims=True)
    var = jnp.mean(jnp.square(xf - mu), axis=-1, keepdims=True)
    return ((xf - mu) * lax.rsqrt(var + LN_EPS) * g + b).astype(x.dtype)


def masked_softmax(s, mask):
    p = jax.nn.softmax(jnp.where(mask, s, NEG_INF), axis=-1)
    return jnp.where(mask, p, 0.0)


def alibi_slopes(n):
    return jnp.exp2(-8.0 * jnp.arange(1, n + 1, dtype=jnp.float32) / n)


def gather_blocks(blocks, idx):
    g = jax.vmap(jax.vmap(lambda bl, ix: bl[ix]))(blocks, idx)
    b, h, q, k, l, d = g.shape
    return g.reshape(b, h, q, k * l, d)


def compress_tokens(kv, pe, w1, w2):
    b, g, s, d = kv.shape
    nb = s // CMP_STRIDE
    sub = kv.reshape(b, g, nb, CMP_STRIDE, d)
    win = jnp.concatenate([sub[:, :, :-1], sub[:, :, 1:]], axis=3) + pe
    win = win.reshape(b, g, nb - 1, CMP_BLOCK * d)
    return jax.nn.gelu(win @ w1) @ w2


def nsa_attention(q, kv, gate_logits, cmp_pe, cmp_w1, cmp_w2):
    b, s, _, d = q.shape
    scale = d ** -0.5
    qg = q.reshape(b, s, NSA_KV_HEADS, NSA_GROUP, d).transpose(0, 2, 3, 1, 4)
    k_c, v_c, k_s, v_s, k_w, v_w = kv.transpose(2, 0, 3, 1, 4)
    slopes = alibi_slopes(NSA_HEADS).reshape(NSA_KV_HEADS, NSA_GROUP)[None, :, :, None, None]
    t = jnp.arange(s)

    kc = compress_tokens(k_c, cmp_pe[0], cmp_w1[0], cmp_w2[0])
    vc = compress_tokens(v_c, cmp_pe[1], cmp_w1[1], cmp_w2[1])
    nc = kc.shape[2]
    c_start = jnp.arange(nc) * CMP_STRIDE
    c_mask = (c_start + CMP_BLOCK - 1)[None, :] <= t[:, None]
    sc = jnp.einsum('bgrtd,bgcd->bgrtc', qg, kc).astype(jnp.float32) * scale
    p_cmp = masked_softmax(sc, c_mask)
    o_cmp = jnp.einsum('bgrtc,bgcd->bgrtd', p_cmp.astype(vc.dtype), vc)

    n_blk = s // SLC_BLOCK
    n_sel = min(SLC_TOPK, n_blk)
    b_start = jnp.arange(n_blk) * SLC_BLOCK
    overlap = ((c_start[:, None] < (b_start + SLC_BLOCK)[None, :])
               & ((c_start + CMP_BLOCK)[:, None] > b_start[None, :])).astype(jnp.float32)
    imp = jnp.einsum('bgrtc,cj->bgtj', p_cmp, overlap)
    cur = (t // SLC_BLOCK)[:, None]
    j = jnp.arange(n_blk)[None, :]
    forced = (j == 0) | (j == cur) | (j == cur - 1)
    imp = jnp.where(forced, FORCE_SCORE, jnp.where(j > cur, -FORCE_SCORE, imp))
    sel = lax.top_k(imp, n_sel)[1]
    ks_blk = k_s.reshape(b, NSA_KV_HEADS, n_blk, SLC_BLOCK, d)
    vs_blk = v_s.reshape(b, NSA_KV_HEADS, n_blk, SLC_BLOCK, d)

    def slc_chunk(ci):
        t0 = ci * SLC_QCHUNK
        qc = lax.dynamic_slice_in_dim(qg, t0, SLC_QCHUNK, axis=3)
        ic = lax.dynamic_slice_in_dim(sel, t0, SLC_QCHUNK, axis=2)
        kg = gather_blocks(ks_blk, ic)
        vg = gather_blocks(vs_blk, ic)
        pos = (ic[..., None] * SLC_BLOCK + jnp.arange(SLC_BLOCK)).reshape(b, NSA_KV_HEADS, SLC_QCHUNK, n_sel * SLC_BLOCK)
        dist = ((t0 + jnp.arange(SLC_QCHUNK))[:, None] - pos)[:, :, None]
        sl = jnp.einsum('bgrqd,bgqkd->bgrqk', qc, kg).astype(jnp.float32) * scale - slopes * dist
        p = masked_softmax(sl, dist >= 0)
        return jnp.einsum('bgrqk,bgqkd->bgrqd', p.astype(vg.dtype), vg)

    o_slc = lax.map(slc_chunk, jnp.arange(s // SLC_QCHUNK))
    o_slc = jnp.moveaxis(o_slc, 0, 3).reshape(b, NSA_KV_HEADS, NSA_GROUP, s, d)

    kw_p = jnp.pad(k_w, ((0, 0), (0, 0), (WINDOW, 0), (0, 0)))
    vw_p = jnp.pad(v_w, ((0, 0), (0, 0), (WINDOW, 0), (0, 0)))

    def win_chunk(ci):
        t0 = ci * WIN_QCHUNK
        qc = lax.dynamic_slice_in_dim(qg, t0, WIN_QCHUNK, axis=3)
        kb = lax.dynamic_slice_in_dim(kw_p, t0, WIN_QCHUNK + WINDOW, axis=2)
        vb = lax.dynamic_slice_in_dim(vw_p, t0, WIN_QCHUNK + WINDOW, axis=2)
        pos = t0 - WINDOW + jnp.arange(WIN_QCHUNK + WINDOW)
        dist = (t0 + jnp.arange(WIN_QCHUNK))[:, None] - pos[None, :]
        mask = (dist >= 0) & (dist < WINDOW) & (pos >= 0)[None, :]
        sw = jnp.einsum('bgrqd,bgkd->bgrqk', qc, kb).astype(jnp.float32) * scale - slopes * dist
        p = masked_softmax(sw, mask)
        return jnp.einsum('bgrqk,bgkd->bgrqd', p.astype(vb.dtype), vb)

    o_win = lax.map(win_chunk, jnp.arange(s // WIN_QCHUNK))
    o_win = jnp.moveaxis(o_win, 0, 3).reshape(b, NSA_KV_HEADS, NSA_GROUP, s, d)

    g = jax.nn.sigmoid(gate_logits).reshape(b, s, NSA_KV_HEADS, NSA_GROUP, 3).transpose(0, 2, 3, 1, 4)
    o = g[..., 0:1] * o_cmp + g[..., 1:2] * o_slc + g[..., 2:3] * o_win
    return o.transpose(0, 3, 1, 2, 4).reshape(b, s, NSA_WIDTH)


def moba_attention(q, k, v):
    b, s, h, d = q.shape
    scale = d ** -0.5
    q, k, v = (a.transpose(0, 2, 1, 3) for a in (q, k, v))
    n_blk = -(-s // MOBA_BLOCK)
    pad = n_blk * MOBA_BLOCK - s
    kb = jnp.pad(k, ((0, 0), (0, 0), (0, pad), (0, 0))).reshape(b, h, n_blk, MOBA_BLOCK, d)
    vb = jnp.pad(v, ((0, 0), (0, 0), (0, pad), (0, 0))).reshape(b, h, n_blk, MOBA_BLOCK, d)
    k_mean = jnp.mean(kb, axis=3)
    n_top = min(MOBA_TOPK, n_blk)
    n_s = n_top * MOBA_BLOCK
    slopes = alibi_slopes(h)[None, :, None, None]

    def chunk(ci):
        t0 = ci * MOBA_QCHUNK
        ib = t0 // MOBA_BLOCK
        qc = lax.dynamic_slice_in_dim(q, t0, MOBA_QCHUNK, axis=2)
        tq = t0 + jnp.arange(MOBA_QCHUNK)
        gate = jnp.einsum('bhqd,bhjd->bhqj', qc, k_mean).astype(jnp.float32)
        gate = jnp.where(jnp.arange(n_blk) < ib, gate, NEG_INF)
        sel = lax.top_k(gate, n_top)[1]
        valid = jnp.repeat(jnp.arange(n_top) < ib, MOBA_BLOCK)
        kg = gather_blocks(kb, sel)
        vg = gather_blocks(vb, sel)
        pos_sel = (sel[..., None] * MOBA_BLOCK + jnp.arange(MOBA_BLOCK)).reshape(b, h, MOBA_QCHUNK, n_s)
        s_sel = jnp.einsum('bhqd,bhqkd->bhqk', qc, kg).astype(jnp.float32) * scale - slopes * (tq[:, None] - pos_sel)
        k_own = lax.dynamic_index_in_dim(kb, ib, axis=2, keepdims=False)
        v_own = lax.dynamic_index_in_dim(vb, ib, axis=2, keepdims=False)
        d_own = tq[:, None] - (ib * MOBA_BLOCK + jnp.arange(MOBA_BLOCK))[None, :]
        s_own = jnp.einsum('bhqd,bhkd->bhqk', qc, k_own).astype(jnp.float32) * scale - slopes * d_own
        mask = jnp.concatenate([jnp.broadcast_to(valid, s_sel.shape), jnp.broadcast_to(d_own >= 0, s_own.shape)], axis=-1)
        p = masked_softmax(jnp.concatenate([s_sel, s_own], axis=-1), mask).astype(v.dtype)
        return (jnp.einsum('bhqk,bhqkd->bhqd', p[..., :n_s], vg)
                + jnp.einsum('bhqk,bhkd->bhqd', p[..., n_s:], v_own))

    o = lax.map(chunk, jnp.arange(s // MOBA_QCHUNK))
    o = jnp.moveaxis(o, 0, 2).reshape(b, h, s, d)
    return o.transpose(0, 2, 1, 3).reshape(b, s, h * d)


def short_conv_mixer(h, b_gate, c_gate, conv_w):
    u = c_gate * h
    y = lax.conv_general_dilated(u, conv_w[:, None, :], window_strides=(1,), padding=[(CONV_K - 1, 0)],
                                 dimension_numbers=('NWC', 'WIO', 'NWC'), feature_group_count=CONV_CH)
    return b_gate * y


def hybrid_mixer(x, w_in, cmp_pe, cmp_w1, cmp_w2, conv_w, w_branch, w_out):
    b, s, _ = x.shape
    z = x @ w_in
    sizes = [NSA_WIDTH, NSA_KV_COLS, NSA_GATE_COLS, MOBA_COLS, CONV_COLS, MERGE_COLS]
    nsa_q, nsa_kv, nsa_g, moba_qkv, conv_in, merge_g = jnp.split(z, np.cumsum(sizes)[:-1].tolist(), axis=-1)
    y_a = nsa_attention(nsa_q.reshape(b, s, NSA_HEADS, HEAD_DIM),
                        nsa_kv.reshape(b, s, 6, NSA_KV_HEADS, HEAD_DIM),
                        nsa_g.reshape(b, s, NSA_HEADS, 3), cmp_pe, cmp_w1, cmp_w2)
    qkv = moba_qkv.reshape(b, s, 3, MOBA_HEADS, HEAD_DIM)
    y_b = moba_attention(qkv[:, :, 0], qkv[:, :, 1], qkv[:, :, 2])
    h_c, b_c, c_c = jnp.split(conv_in, 3, axis=-1)
    y_c = short_conv_mixer(h_c, b_c, c_c, conv_w)
    gates = jax.nn.sigmoid(merge_g).reshape(b, s, N_BRANCH, D_MODEL)
    merged = (gates[:, :, 0] * (y_a @ w_branch[0])
              + gates[:, :, 1] * (y_b @ w_branch[1])
              + gates[:, :, 2] * (y_c @ w_branch[2]))
    return merged @ w_out


def memory_cross_attention(x, mem, wq, wkv, wo):
    b, s, _ = x.shape
    m = mem.shape[1]
    q = (x @ wq).reshape(b, s, XATTN_HEADS, XATTN_HEAD_DIM)
    kv = (mem @ wkv).reshape(b, m, 2, XATTN_HEADS, XATTN_HEAD_DIM)
    k, v = kv[:, :, 0], kv[:, :, 1]
    sc = jnp.einsum('bshd,bmhd->bhsm', q, k).astype(jnp.float32) * XATTN_HEAD_DIM ** -0.5
    p = jax.nn.softmax(sc, axis=-1).astype(v.dtype)
    o = jnp.einsum('bhsm,bmhd->bshd', p, v).reshape(b, s, XATTN_WIDTH)
    return o @ wo


def route(xf, router_w, router_b):
    t = xf.shape[0]
    s = jax.nn.sigmoid((xf @ router_w).astype(jnp.float32))
    sb = s + router_b.astype(jnp.float32)
    grp = sb.reshape(t, N_GROUPS, N_EXPERTS // N_GROUPS)
    g_score = jnp.sum(lax.top_k(grp, 2)[0], axis=-1)
    g_idx = lax.top_k(g_score, TOPK_GROUPS)[1]
    g_mask = jnp.any(g_idx[..., None] == jnp.arange(N_GROUPS), axis=-2)
    e_mask = jnp.repeat(g_mask, N_EXPERTS // N_GROUPS, axis=-1)
    idx = lax.top_k(jnp.where(e_mask, sb, NEG_INF), TOP_K)[1]
    w = jnp.take_along_axis(s, idx, axis=-1)
    w = w / jnp.sum(w, axis=-1, keepdims=True) * ROUTE_SCALE
    return idx, w.astype(xf.dtype)


def routed_experts(xf, idx, wts, exp_w13, exp_w2):
    t, dm = xf.shape
    n_a = t * TOP_K
    flat_e = idx.reshape(-1)
    flat_tok = jnp.arange(n_a) // TOP_K
    flat_w = wts.reshape(-1)
    order = jnp.argsort(flat_e)
    se, stok, sw = flat_e[order], flat_tok[order], flat_w[order]
    counts = jnp.bincount(flat_e, length=N_EXPERTS)
    pcounts = (counts + MOE_BLOCK - 1) // MOE_BLOCK * MOE_BLOCK
    starts = jnp.cumsum(counts) - counts
    pends = jnp.cumsum(pcounts)
    pstarts = pends - pcounts
    dest = pstarts[se] + jnp.arange(n_a) - starts[se]
    n_blocks = -(-n_a // MOE_BLOCK) + N_EXPERTS
    n_pad = n_blocks * MOE_BLOCK
    row_tok = jnp.full((n_pad,), t, jnp.int32).at[dest].set(stok.astype(jnp.int32))
    row_w = jnp.zeros((n_pad,), xf.dtype).at[dest].set(sw)
    block_e = jnp.minimum(jnp.searchsorted(pends, jnp.arange(n_blocks) * MOE_BLOCK, side='right'), N_EXPERTS - 1)
    x_pad = jnp.concatenate([xf, jnp.zeros((1, dm), xf.dtype)], axis=0)

    def run_block(args):
        tok, w, e = args
        xb = x_pad[tok]
        a, g = jnp.split(xb @ exp_w13[e], 2, axis=-1)
        return ((jax.nn.silu(a) * g) @ exp_w2[e]) * w[:, None]

    out = lax.map(run_block, (row_tok.reshape(n_blocks, MOE_BLOCK), row_w.reshape(n_blocks, MOE_BLOCK), block_e))
    y = jax.ops.segment_sum(out.reshape(n_pad, dm), row_tok, num_segments=t + 1)
    return y[:t]


def moe_ffn(x, router_w, router_b, exp_w13, exp_w2, shared_w13, shared_w2):
    b, s, dm = x.shape
    xf = x.reshape(b * s, dm)
    idx, wts = route(xf, router_w, router_b)
    routed = routed_experts(xf, idx, wts, exp_w13, exp_w2)
    a, g = jnp.split(xf @ shared_w13, 2, axis=-1)
    shared = (jax.nn.silu(a) * g) @ shared_w2
    return (routed + shared).reshape(b, s, dm)


def setup_inputs(seed: int = 0) -> dict:
    key = jax.random.key(seed)
    ks = jax.random.split(key, 32)
    L, D = DEPTH, D_MODEL

    def nrm(k, shape, scale):
        return jax.random.normal(k, shape, jnp.float32) * scale

    return {
        'x': nrm(ks[0], (BATCH, SEQ, D), 1.0),
        'mem': nrm(ks[1], (BATCH, MEM_LEN, D), 1.0),
        'w_in': nrm(ks[2], (L, D, N_IN), D ** -0.5),
        'cmp_pe': nrm(ks[3], (L, 2, CMP_BLOCK, HEAD_DIM), 0.02),
        'cmp_w1': nrm(ks[4], (L, 2, CMP_BLOCK * HEAD_DIM, CMP_HIDDEN), (CMP_BLOCK * HEAD_DIM) ** -0.5),
        'cmp_w2': nrm(ks[5], (L, 2, CMP_HIDDEN, HEAD_DIM), CMP_HIDDEN ** -0.5),
        'conv_w': nrm(ks[6], (L, CONV_K, CONV_CH), CONV_K ** -0.5),
        'w_branch': nrm(ks[7], (L, N_BRANCH, MIX_WIDTH, D), MIX_WIDTH ** -0.5 * DN_BETA),
        'w_out': nrm(ks[8], (L, D, D), D ** -0.5 * DN_BETA),
        'ln1_g': 1.0 + nrm(ks[9], (L, D), 0.02),
        'ln1_b': nrm(ks[10], (L, D), 0.02),
        'xattn_wq': nrm(ks[11], (L, D, XATTN_WIDTH), D ** -0.5),
        'xattn_wkv': jnp.concatenate([nrm(ks[12], (L, D, XATTN_WIDTH), D ** -0.5),
                                      nrm(ks[13], (L, D, XATTN_WIDTH), D ** -0.5 * DN_BETA)], axis=-1),
        'xattn_wo': nrm(ks[14], (L, XATTN_WIDTH, D), XATTN_WIDTH ** -0.5 * DN_BETA),
        'ln2_g': 1.0 + nrm(ks[15], (L, D), 0.02),
        'ln2_b': nrm(ks[16], (L, D), 0.02),
        'router_w': nrm(ks[17], (L, D, N_EXPERTS), D ** -0.5),
        'router_b': nrm(ks[18], (L, N_EXPERTS), 0.01),
        'exp_w13': nrm(ks[19], (L, N_EXPERTS, D, 2 * EXPERT_DIM), D ** -0.5),
        'exp_w2': nrm(ks[20], (L, N_EXPERTS, EXPERT_DIM, D), EXPERT_DIM ** -0.5 * DN_BETA),
        'shared_w13': nrm(ks[21], (L, D, 2 * SHARED_DIM), D ** -0.5),
        'shared_w2': nrm(ks[22], (L, SHARED_DIM, D), SHARED_DIM ** -0.5 * DN_BETA),
        'ln3_g': 1.0 + nrm(ks[23], (L, D), 0.02),
        'ln3_b': nrm(ks[24], (L, D), 0.02),
    }


def reference(x, mem, w_in, cmp_pe, cmp_w1, cmp_w2, conv_w, w_branch, w_out, ln1_g, ln1_b,
              xattn_wq, xattn_wkv, xattn_wo, ln2_g, ln2_b, router_w, router_b, exp_w13, exp_w2,
              shared_w13, shared_w2, ln3_g, ln3_b):
    h = x
    for l in range(DEPTH):
        h = layer_norm(DN_ALPHA * h + hybrid_mixer(h, w_in[l], cmp_pe[l], cmp_w1[l], cmp_w2[l], conv_w[l], w_branch[l], w_out[l]),
                       ln1_g[l], ln1_b[l])
        h = layer_norm(DN_ALPHA * h + memory_cross_attention(h, mem, xattn_wq[l], xattn_wkv[l], xattn_wo[l]),
                       ln2_g[l], ln2_b[l])
        h = layer_norm(DN_ALPHA * h + moe_ffn(h, router_w[l], router_b[l], exp_w13[l], exp_w2[l], shared_w13[l], shared_w2[l]),
                       ln3_g[l], ln3_b[l])
    return h
```

```cpp
#include <hip/hip_runtime.h>
#include <cstdio>
#include <cstdint>

#ifndef REPMASK
#define REPMASK 0x0u
#endif
constexpr int DM = 1024, BATCH = 8, SEQ = 4096, DEPTH = 2, T = BATCH * SEQ;
constexpr int MEM_LEN = 256, TM = BATCH * MEM_LEN;
constexpr int N_IN = 7448, N_INP = 7680;
constexpr int NEXP = 256, TOPK = 8, EDIM = 256;
constexpr float LN_EPS = 1e-5f;
constexpr float DN_ALPHA = 1.4142135623730951f;
constexpr float LOG2E = 1.4426950408889634f;
constexpr float QSC64 = 0.125f * LOG2E;
constexpr float QSC128 = 0.08838834764831845f * LOG2E;
constexpr int NHM = 40;
constexpr int NPAD_ROWS = T * TOPK + NEXP * 256;
constexpr int NBLK_MAX = NPAD_ROWS / 256;

constexpr size_t MiB = 1u << 20;
constexpr size_t CTL_BYTES = 1 * MiB;
constexpr size_t WL_WIN = 0;
constexpr size_t WL_W1C = WL_WIN + (size_t)N_INP * DM * 2;
constexpr size_t WL_W2C = WL_W1C + (size_t)2 * 256 * 2048 * 2;
constexpr size_t WL_WB = WL_W2C + (size_t)2 * 256 * 256 * 2;
constexpr size_t WL_WOUT = WL_WB + (size_t)3 * 1024 * 512 * 2;
constexpr size_t WL_WQ = WL_WOUT + (size_t)1024 * 1024 * 2;
constexpr size_t WL_WKV = WL_WQ + (size_t)512 * 1024 * 2;
constexpr size_t WL_WO = WL_WKV + (size_t)1024 * 1024 * 2;
constexpr size_t WL_WRS = WL_WO + (size_t)1024 * 512 * 2;
constexpr size_t WL_WS2 = WL_WRS + (size_t)768 * 1024 * 2;
constexpr size_t WL_W13 = WL_WS2 + (size_t)1024 * 256 * 2;
constexpr size_t WL_W2 = WL_W13 + (size_t)NEXP * 512 * 1024 * 2;
constexpr size_t WL_CB = WL_W2 + (size_t)NEXP * 1024 * 256 * 2;
constexpr size_t WL_BYTES = ((WL_CB + 2 * 256 * 4 + 4095) / 4096) * 4096;
constexpr size_t WS_W = CTL_BYTES;
constexpr size_t WS_ACT = WS_W + DEPTH * WL_BYTES;
constexpr size_t A_HF = 0;
constexpr size_t A_HB = A_HF + (size_t)T * DM * 4;
constexpr size_t A_HM = A_HB + (size_t)(T + 8) * DM * 2;
constexpr size_t A_CMP = A_HM + (size_t)BATCH * NHM * SEQ * 64 * 2;
constexpr size_t A_CONV = A_CMP + (size_t)BATCH * 4 * SEQ * 64 * 2 + 8192;
constexpr size_t A_MG = A_CONV + (size_t)T * 1536 * 2;
constexpr size_t A_NG = A_MG + (size_t)T * 3072 * 2;
constexpr size_t A_H1 = A_NG + (size_t)T * 24 * 4;
constexpr size_t A_CKV = A_H1 + (size_t)8192 * 256 * 2;
constexpr size_t A_KMEAN = A_CKV + (size_t)32 * 256 * 64 * 2;
constexpr size_t A_Y3 = A_KMEAN + (size_t)BATCH * 8 * 16 * 64 * 4;
constexpr size_t A_MERGED = A_Y3 + (size_t)3 * T * 512 * 2;
constexpr size_t A_DELTA = A_MERGED + (size_t)T * DM * 2;
constexpr size_t A_DELTAB = A_DELTA + (size_t)T * DM * 4;
constexpr size_t A_QX = A_DELTAB + (size_t)T * DM * 2;
constexpr size_t A_MEMB = A_QX + (size_t)T * 512 * 2;
constexpr size_t A_KVM = A_MEMB + (size_t)TM * DM * 2;
constexpr size_t A_OX = A_KVM + (size_t)DEPTH * TM * DM * 2;
constexpr size_t A_RS = A_OX + (size_t)T * 512 * 2;
constexpr size_t A_HS = A_RS + (size_t)T * 256 * 4;
constexpr size_t A_RIDX = A_HS + (size_t)T * 256 * 2;
constexpr size_t A_RW = A_RIDX + (size_t)T * 8 * 4;
constexpr size_t A_RRANK = A_RW + (size_t)T * 8 * 4;
constexpr size_t A_RPOS = A_RRANK + (size_t)T * 8 * 4;
constexpr size_t A_ROWW = A_RPOS + (size_t)T * 8 * 4;
constexpr size_t A_BLKE = A_ROWW + (size_t)NPAD_ROWS * 4;
constexpr size_t A_XG = A_BLKE + (size_t)(NBLK_MAX + 64) * 4;
constexpr size_t A_HE = A_XG + (size_t)NPAD_ROWS * DM * 2;
constexpr size_t A_END = A_HE + (size_t)NPAD_ROWS * 256 * 2;
constexpr size_t WS_END = WS_ACT + A_END;

constexpr int CW_BAR = 4096;
constexpr int CW_CNT = 16384;
constexpr int CW_GRP = 24576;

constexpr int RING_BYTES = 135168;
constexpr int LDSCTL_OFF = RING_BYTES, MISC_OFF = LDSCTL_OFF + 320;
constexpr int LDS_BYTES = 147456;
constexpr int NWAVES = 8;

#define GAS __attribute__((address_space(1)))
#define LAS __attribute__((address_space(3)))
typedef unsigned short bf16;
typedef unsigned v4u __attribute__((ext_vector_type(4)));
typedef unsigned v2u __attribute__((ext_vector_type(2)));
typedef float f32x4 __attribute__((ext_vector_type(4)));
typedef float f32x16 __attribute__((ext_vector_type(16)));
typedef short bf16x8 __attribute__((ext_vector_type(8)));
typedef short s16x4 __attribute__((ext_vector_type(4)));
#define LDS_WAIT() asm volatile("s_waitcnt lgkmcnt(0)" ::: "memory")
#define VM_WAIT() asm volatile("s_waitcnt vmcnt(0)" ::: "memory")
__device__ __forceinline__ unsigned f2bf(float f) { unsigned u = __builtin_bit_cast(unsigned, f); return (u + 0x7fffu + ((u >> 16) & 1u)) >> 16; }
__device__ __forceinline__ unsigned pk2(float lo, float hi) { return f2bf(lo) | (f2bf(hi) << 16); }
__device__ __forceinline__ float bf2f(unsigned short b) { return __builtin_bit_cast(float, ((unsigned)b) << 16); }
__device__ __forceinline__ float bflo(unsigned w) { return __builtin_bit_cast(float, w << 16); }
__device__ __forceinline__ float bfhi(unsigned w) { return __builtin_bit_cast(float, w & 0xffff0000u); }
__device__ __forceinline__ float sigmoidf_(float x) { return 1.0f / (1.0f + __expf(-x)); }
__device__ __forceinline__ float gelu_tanh(float x) { const float y = 0.7978845608028654f * (x + 0.044715f * x * x * x); const float e = __expf(2.0f * y); const float th = 1.0f - 2.0f / (e + 1.0f); return 0.5f * x * (1.0f + th); }

__device__ __forceinline__ int lane_now() { int l; asm volatile("v_mbcnt_lo_u32_b32 %0, -1, 0\n\tv_mbcnt_hi_u32_b32 %0, -1, %0" : "=v"(l)); return l; }
#define XB_TMO      128
#define XB_XCNT(j)  (256  + 64 * (j))
#define XB_XSUB(j)  (1280 + 64 * (j))
#define XB_XGEN(j)  (2304 + 64 * (j))
#define XB_TOP      3328
#define XB_TOPGEN   3392
#define XCD_BAR_WORDS 3456
#define XB_SPIN_CAP (1u << 18)
__device__ __forceinline__ unsigned xb_ld(unsigned* p)              { return __hip_atomic_load(p, __ATOMIC_RELAXED, __HIP_MEMORY_SCOPE_AGENT); }
__device__ __forceinline__ unsigned xb_add(unsigned* p, unsigned v) { return __hip_atomic_fetch_add(p, v, __ATOMIC_RELAXED, __HIP_MEMORY_SCOPE_AGENT); }
__device__ __forceinline__ unsigned xb_xcc_id() { return (unsigned)__builtin_amdgcn_s_getreg((3 << 11) | 20) & 0xFu; }
#define XB_SPIN(cond, bar) do { unsigned _sp = 0; while (cond) { __builtin_amdgcn_s_sleep(1); \
    if ((++_sp & 255u) == 0u) { if (xb_ld(&(bar)[XB_TMO])) break; if (_sp > XB_SPIN_CAP) { atomicAdd(&(bar)[XB_TMO], 1u); break; } } } } while (0)
struct XcdBarrier { unsigned* bar; unsigned x; volatile LAS unsigned* st; };
__device__ __forceinline__ XcdBarrier xcd_barrier_post(unsigned* bar, volatile LAS unsigned* st, bool leader) {
    XcdBarrier b; b.bar = bar; b.x = xb_xcc_id(); b.st = st;
    if (leader) (void)xb_add(&bar[XB_XCNT(b.x)], 1u);
    return b;
}
__device__ __forceinline__ void xcd_barrier_complete(unsigned* bar, unsigned x, unsigned& nloc, unsigned& nx) {
    const unsigned G = gridDim.x * gridDim.y * gridDim.z;
    unsigned sum, cnt, mine, sp = 0u;
    for (;;) {
        sum = 0u; cnt = 0u; mine = 0u;
#pragma unroll
        for (unsigned j = 0; j < 16; ++j) { const unsigned c = xb_ld(&bar[XB_XCNT(j)]); sum += c; cnt += (c > 0u) ? 1u : 0u; mine = (j == x) ? c : mine; }
        if (sum == G) break;
        __builtin_amdgcn_s_sleep(1);
        if ((++sp & 255u) == 0u) { if (xb_ld(&bar[XB_TMO])) break; if (sp > XB_SPIN_CAP) { atomicAdd(&bar[XB_TMO], 1u); break; } }
    }
    nloc = mine > 0u ? mine : 1u; nx = cnt > 0u ? cnt : 1u;
}
__device__ __forceinline__ void xcd_barrier(const XcdBarrier& b, bool leader) {
    asm volatile("s_waitcnt vmcnt(0)" ::: "memory");
    __syncthreads();
    if (leader) {
        unsigned* bar = b.bar; asm volatile("" : "+s"(bar));
        __builtin_amdgcn_s_waitcnt(0);
        unsigned nloc = b.st[0], nx = b.st[1];
        if (nloc == 0u) { xcd_barrier_complete(bar, b.x, nloc, nx); b.st[0] = nloc; b.st[1] = nx; }
        const unsigned old = xb_add(&bar[XB_XSUB(b.x)], 1u);
        const unsigned gen = old / nloc;
        if (old + 1u == (gen + 1u) * nloc) {
            __builtin_amdgcn_fence(__ATOMIC_RELEASE, "agent");
            asm volatile("s_waitcnt vmcnt(0)" ::: "memory");
            const unsigned og = xb_add(&bar[XB_TOP], 1u);
            const unsigned tg = og / nx;
            if (og + 1u == (tg + 1u) * nx) xb_add(&bar[XB_TOPGEN], 1u);
            else XB_SPIN(xb_ld(&bar[XB_TOPGEN]) == tg, bar);
            __builtin_amdgcn_fence(__ATOMIC_ACQUIRE, "agent");
            xb_add(&bar[XB_XGEN(b.x)], 1u);
            asm volatile("s_waitcnt vmcnt(0)" ::: "memory");
        } else {
            XB_SPIN(xb_ld(&bar[XB_XGEN(b.x)]) == gen, bar);
            __builtin_amdgcn_fence(__ATOMIC_ACQUIRE, "agent");
            asm volatile("s_waitcnt vmcnt(0)" ::: "memory");
        }
    }
    __syncthreads();
}

namespace pg8 {
#define PG8_LAS __attribute__((address_space(3)))
typedef unsigned short bf16_t;
typedef unsigned u32x4 __attribute__((ext_vector_type(4)));
constexpr int BM = 256, BK = 64, HALF = 128, HTB = HALF * BK * 2, STAGE_BYTES = 8 * HTB, NXCD = 8, WGM = 8;
__host__ __device__ __forceinline__ int lds_byte(int r, int c) { const int st = (r >> 4) * 2 + (c >> 5), rr = r & 15, cc = c & 31, ob = rr * 64 + cc * 2; return st * 1024 + (ob ^ (((ob >> 9) & 1) << 5)); }
__host__ __device__ __forceinline__ void stage_rc(int b, int& R, int& C) { const int st = b / 1024, sb = b % 1024, swz = sb ^ (((sb >> 9) & 1) << 5); R = (st >> 1) * 16 + swz / 64; C = (st & 1) * 32 + (swz % 64) / 2; }
__host__ __device__ __forceinline__ int perm32(int rho) { const int n = rho >> 4, i = rho & 15; return 8 * (i >> 2) + 4 * n + (i & 3); }
struct Unit { int pm, pn; int aux; };
struct Gemm { const bf16_t* A; const bf16_t* Bt; int lda, K; const int* gidx; };
struct StaticOrder {
    int nM, nN, nwg, G, c, i0, imax;
    __host__ __device__ void init(int M, int N, int G_, int c_) { nM = M / BM; nN = N / BM; nwg = nM * nN; G = G_; c = c_; i0 = 0; imax = 1 << 30; }
    __host__ __device__ bool next(int i, Unit& u) const {
        if (i >= imax) return false;
        const long L = (long)(i0 + i) * G + c; if (L >= nwg) return false;
        int wgid = (int)L; { const int q = nwg / NXCD, r = nwg % NXCD, xcd = wgid % NXCD, off = wgid / NXCD; wgid = (xcd < r ? xcd * (q + 1) : r * (q + 1) + (xcd - r) * q) + off; }
        const int nig = WGM * nN, gid = wgid / nig, fm = gid * WGM, gsz = (nM - fm) < WGM ? (nM - fm) : WGM;
        u.pm = fm + ((wgid % nig) % gsz); u.pn = (wgid % nig) / gsz; return true;
    }
};
__device__ __forceinline__ unsigned cvt_pk_bf16(float lo, float hi) { unsigned r; asm volatile("v_cvt_pk_bf16_f32 %0, %1, %2" : "=v"(r) : "v"(lo), "v"(hi)); return r; }

template <class Epi, class Sched, bool ALIGN_EPI = true, bool SP2 = true, bool GATHER = false>
__device__ __forceinline__ void gemm_phase(PG8_LAS unsigned char* lds, const Gemm g, const Sched& S, const Epi& E, int wave0) {
    int tid_ = (wave0 << 6) | lane_now(); asm volatile("" : "+v"(tid_));
    const int tid = tid_, wid = __builtin_amdgcn_readfirstlane(tid >> 6), lane = tid & 63, wr = wid >> 2, wc = wid & 3, fr = lane & 15, fq = lane >> 4;
    int K_ = g.K; asm volatile("" : "+s"(K_));
    const int K = K_, nt = K / BK, lda = g.lda;
    static_assert(!GATHER || SP2, "gather needs the SP2 loop");
    unsigned voffA[2], voffB[2];
#pragma unroll
    for (int i = 0; i < 2; ++i) { int R, C; stage_rc(tid * 16 + i * 8192, R, C); const int Rb = Epi::PERM ? ((R & ~31) + perm32(R & 31)) : R;
        voffA[i] = (unsigned)(R * lda + C) * 2u; voffB[i] = (unsigned)(Rb * K + C) * 2u; }
    unsigned gA[2][2];
#define PG8_GLOAD(dst, pm_) do { int tq_ = tid; asm volatile("" : "+v"(tq_)); const char* gb_ = (const char*)g.gidx + (size_t)(pm_) * 1024; \
        _Pragma("unroll") for (int i_ = 0; i_ < 2; ++i_) { int R_, C_; stage_rc(tq_ * 16 + i_ * 8192, R_, C_); _Pragma("unroll") for (int h_ = 0; h_ < 2; ++h_) \
        dst[h_][i_] = ((unsigned)(*(const int*)(gb_ + (unsigned)((h_ * 128 + R_) * 4))) * (unsigned)lda + (unsigned)C_) * 2u; } } while (0)
    const size_t kstep = (size_t)(BK * 2);
    const size_t hstepA = (size_t)HALF * lda * 2, hstepB = (size_t)HALF * K * 2;
    const size_t tstepA = 2 * hstepA, tstepB = 2 * hstepB;
    const unsigned ldsw = (unsigned)wid * 1024u;
    const int aoff = lds_byte(wr * 64 + fr, fq * 8), boff = lds_byte(wc * 32 + fr, fq * 8);
#define PG8_SA(b, h) (((b) * 2 + (h)) * HTB)
#define PG8_SB(b, h) ((4 + (b) * 2 + (h)) * HTB)
#define PG8_STAGE(bufoff, gbase, voff) do { _Pragma("unroll") for (int _i = 0; _i < 2; ++_i) \
        __builtin_amdgcn_global_load_lds((const unsigned*)((const char*)(gbase) + (voff)[_i]), (PG8_LAS unsigned*)(lds + (bufoff) + ldsw + _i * 8192), 16, 0, 0); } while (0)
#define PG8_LDA(dst, b, h) do { _Pragma("unroll") for (int m = 0; m < 4; ++m) _Pragma("unroll") for (int k = 0; k < 2; ++k) dst[m][k] = *(const PG8_LAS bf16x8*)(lds + PG8_SA(b, h) + aoff + m * 2048 + k * 1024); } while (0)
#define PG8_LDB(dst, b, h) do { _Pragma("unroll") for (int n = 0; n < 2; ++n) _Pragma("unroll") for (int k = 0; k < 2; ++k) dst[n][k] = *(const PG8_LAS bf16x8*)(lds + PG8_SB(b, h) + boff + n * 2048 + k * 1024); } while (0)
#define PG8_MMA(ai, bj, At, Bt) do { __builtin_amdgcn_s_setprio(1); _Pragma("unroll") for (int m = 0; m < 4; ++m) _Pragma("unroll") for (int n = 0; n < 2; ++n) _Pragma("unroll") for (int k = 0; k < 2; ++k) \
        acc[ai][bj][m][n] = __builtin_amdgcn_mfma_f32_16x16x32_bf16(Bt[n][k], At[m][k], acc[ai][bj][m][n], 0, 0, 0); __builtin_amdgcn_s_setprio(0); } while (0)
#define PG8_WAIT_V(n) asm volatile("s_waitcnt vmcnt(" #n ")" ::: "memory")
#define PG8_WAIT_L(n) asm volatile("s_waitcnt lgkmcnt(" #n ")" ::: "memory")
#define PG8_BAR __builtin_amdgcn_s_barrier()
#define PG8_SCHED __builtin_amdgcn_sched_barrier(0)
    Unit cur, nxt; int ui = 0;
    if (!S.next(0, cur)) return;
    f32x4 acc[2][2][4][2];
#pragma unroll
    for (int a = 0; a < 2; ++a)
#pragma unroll
        for (int b = 0; b < 2; ++b)
#pragma unroll
            for (int m = 0; m < 4; ++m)
#pragma unroll
                for (int n = 0; n < 2; ++n) acc[a][b][m][n] = (f32x4){0.f, 0.f, 0.f, 0.f};
    bf16x8 At[4][2], B0[2][2], B1[2][2];
    const char* cA = (const char*)g.A + (GATHER ? (size_t)0 : (size_t)cur.pm * tstepA); const char* cB = (const char*)g.Bt + (size_t)cur.pn * tstepB;
    if constexpr (GATHER) { PG8_GLOAD(gA, cur.pm); }
    if constexpr (SP2) {
        PG8_STAGE(PG8_SB(0, 0), cB, voffB); PG8_STAGE(PG8_SB(0, 1), cB + hstepB, voffB); if constexpr (GATHER) { PG8_STAGE(PG8_SA(0, 0), cA, gA[0]); PG8_STAGE(PG8_SA(0, 1), cA, gA[1]); } else { PG8_STAGE(PG8_SA(0, 0), cA, voffA); PG8_STAGE(PG8_SA(0, 1), cA + hstepA, voffA); }
        if (wr == 1) PG8_BAR;
        PG8_WAIT_V(2); PG8_BAR;
        PG8_STAGE(PG8_SB(1, 0), cB + kstep, voffB); if constexpr (GATHER) { PG8_STAGE(PG8_SA(1, 0), cA + kstep, gA[0]); } else { PG8_STAGE(PG8_SA(1, 0), cA + kstep, voffA); } PG8_STAGE(PG8_SB(1, 1), cB + hstepB + kstep, voffB);
        PG8_WAIT_V(6); PG8_BAR;
    } else {
        PG8_STAGE(PG8_SB(0, 0), cB, voffB); PG8_STAGE(PG8_SA(0, 0), cA, voffA); PG8_STAGE(PG8_SB(0, 1), cB + hstepB, voffB); PG8_STAGE(PG8_SA(0, 1), cA + hstepA, voffA);
        if (wr == 1) PG8_BAR;
        PG8_WAIT_V(4); PG8_BAR;
        PG8_STAGE(PG8_SB(1, 0), cB + kstep, voffB); PG8_STAGE(PG8_SA(1, 0), cA + kstep, voffA); PG8_STAGE(PG8_SB(1, 1), cB + hstepB + kstep, voffB);
        PG8_WAIT_V(6); PG8_BAR;
    }
    for (;;) {
        const bool has_next = S.next(ui + 1, nxt);
        const char* nA = (has_next && !GATHER) ? (const char*)g.A + (size_t)nxt.pm * tstepA : cA; const char* nB = has_next ? (const char*)g.Bt + (size_t)nxt.pn * tstepB : cB;
        unsigned o2[2][2];
        for (int t = 0; t < nt; t += 2) {
            const bool last = (t == nt - 2);
            const char* a1 = cA + (size_t)(t + 1) * kstep;
            const char* a2 = last ? nA : cA + (size_t)(t + 2) * kstep; const char* b2 = last ? nB : cB + (size_t)(t + 2) * kstep;
            const char* a3 = a2 + kstep; const char* b3 = b2 + kstep;
            if constexpr (Epi::MID) { if (t == 8 || t == 16) E.mid(acc, cur, t >> 3, wr, wc, fr, fq); }
            if constexpr (SP2) {
            if constexpr (GATHER) { if (last && has_next) { PG8_GLOAD(o2, nxt.pm); } else {
#pragma unroll
                for (int h_ = 0; h_ < 2; ++h_) { o2[h_][0] = gA[h_][0]; o2[h_][1] = gA[h_][1]; } } }
            PG8_LDB(B0, 0, 0); PG8_LDB(B1, 0, 1); PG8_SCHED; PG8_LDA(At, 0, 0); if constexpr (GATHER) { PG8_STAGE(PG8_SA(1, 1), a1, gA[1]); } else { PG8_STAGE(PG8_SA(1, 1), a1 + hstepA, voffA); }
            PG8_WAIT_V(8); PG8_WAIT_L(0); PG8_BAR; PG8_MMA(0, 0, At, B0); PG8_MMA(0, 1, At, B1); PG8_BAR; PG8_SCHED;
            PG8_LDA(At, 0, 1); PG8_STAGE(PG8_SB(0, 0), b2, voffB); PG8_STAGE(PG8_SB(0, 1), b2 + hstepB, voffB); if constexpr (GATHER) { PG8_STAGE(PG8_SA(0, 0), a2, o2[0]); } else { PG8_STAGE(PG8_SA(0, 0), a2, voffA); }
            PG8_WAIT_V(8); PG8_WAIT_L(0); PG8_BAR; PG8_MMA(1, 0, At, B0); PG8_MMA(1, 1, At, B1); PG8_BAR; PG8_SCHED;
            PG8_LDB(B0, 1, 0); PG8_LDB(B1, 1, 1); PG8_SCHED; PG8_LDA(At, 1, 0); if constexpr (GATHER) { PG8_STAGE(PG8_SA(0, 1), a2, o2[1]); } else { PG8_STAGE(PG8_SA(0, 1), a2 + hstepA, voffA); }
            PG8_WAIT_V(8); PG8_WAIT_L(0); PG8_BAR; PG8_MMA(0, 0, At, B0); PG8_MMA(0, 1, At, B1); PG8_BAR; PG8_SCHED;
            PG8_LDA(At, 1, 1); PG8_STAGE(PG8_SB(1, 0), b3, voffB); PG8_STAGE(PG8_SB(1, 1), b3 + hstepB, voffB); if constexpr (GATHER) { PG8_STAGE(PG8_SA(1, 0), a3, o2[0]); } else { PG8_STAGE(PG8_SA(1, 0), a3, voffA); }
            PG8_WAIT_V(8); PG8_WAIT_L(0); PG8_BAR; PG8_MMA(1, 0, At, B0); PG8_MMA(1, 1, At, B1); PG8_BAR; PG8_SCHED;
            } else {
            PG8_LDB(B0, 0, 0); PG8_SCHED; PG8_LDA(At, 0, 0); PG8_STAGE(PG8_SA(1, 1), a1 + hstepA, voffA);
            PG8_WAIT_L(8); PG8_BAR; PG8_WAIT_L(0); PG8_MMA(0, 0, At, B0); PG8_BAR; PG8_SCHED;
            PG8_LDB(B1, 0, 1); PG8_STAGE(PG8_SB(0, 0), b2, voffB);
            PG8_BAR; PG8_WAIT_L(0); PG8_MMA(0, 1, At, B1); PG8_BAR;
            PG8_LDA(At, 0, 1); PG8_STAGE(PG8_SA(0, 0), a2, voffA);
            PG8_BAR; PG8_WAIT_L(0); PG8_MMA(1, 0, At, B0); PG8_BAR; PG8_SCHED;
            PG8_STAGE(PG8_SB(0, 1), b2 + hstepB, voffB);
            PG8_WAIT_V(6); PG8_BAR; PG8_MMA(1, 1, At, B1); PG8_BAR;
            PG8_LDB(B0, 1, 0); PG8_SCHED; PG8_LDA(At, 1, 0); PG8_STAGE(PG8_SA(0, 1), a2 + hstepA, voffA);
            PG8_WAIT_L(8); PG8_BAR; PG8_WAIT_L(0); PG8_MMA(0, 0, At, B0); PG8_BAR; PG8_SCHED;
            PG8_LDB(B1, 1, 1); PG8_STAGE(PG8_SB(1, 0), b3, voffB);
            PG8_BAR; PG8_WAIT_L(0); PG8_MMA(0, 1, At, B1); PG8_BAR;
            PG8_LDA(At, 1, 1); PG8_STAGE(PG8_SA(1, 0), a3, voffA);
            PG8_BAR; PG8_WAIT_L(0); PG8_MMA(1, 0, At, B0); PG8_BAR; PG8_SCHED;
            PG8_STAGE(PG8_SB(1, 1), b3 + hstepB, voffB);
            PG8_WAIT_V(6); PG8_BAR; PG8_MMA(1, 1, At, B1); PG8_BAR;
            }
        }
        if constexpr (ALIGN_EPI) { if (wr == 0) PG8_BAR; }
        E(acc, cur, wr, wc, fr, fq);
        if (!has_next) break;
#pragma unroll
        for (int a = 0; a < 2; ++a)
#pragma unroll
            for (int b = 0; b < 2; ++b)
#pragma unroll
                for (int m = 0; m < 4; ++m)
#pragma unroll
                    for (int n = 0; n < 2; ++n) acc[a][b][m][n] = (f32x4){0.f, 0.f, 0.f, 0.f};
        cur = nxt; cA = nA; cB = nB; ++ui;
        if constexpr (GATHER) {
#pragma unroll
            for (int h_ = 0; h_ < 2; ++h_) { gA[h_][0] = o2[h_][0]; gA[h_][1] = o2[h_][1]; } }
        if constexpr (ALIGN_EPI) { if (wr == 1) PG8_BAR; }
    }
    PG8_WAIT_V(0);
    if constexpr (!ALIGN_EPI) { if (wr == 0) PG8_BAR; }
    PG8_BAR;
#undef PG8_GLOAD
#undef PG8_SA
#undef PG8_SB
#undef PG8_STAGE
#undef PG8_LDA
#undef PG8_LDB
#undef PG8_MMA
#undef PG8_WAIT_V
#undef PG8_WAIT_L
#undef PG8_BAR
#undef PG8_SCHED
}
}
using pg8::Unit; using pg8::cvt_pk_bf16; using pg8::u32x4;
typedef const f32x4 (&AccRef)[2][2][4][2];

__device__ __forceinline__ void grp_barrier(unsigned* bar, unsigned* gword, unsigned n, bool leader) {
    asm volatile("s_waitcnt vmcnt(0)" ::: "memory");
    __syncthreads();
    if (leader) {
        __builtin_amdgcn_fence(__ATOMIC_RELEASE, "agent");
        asm volatile("s_waitcnt vmcnt(0)" ::: "memory");
        const unsigned old = xb_add(gword, 1u);
        const unsigned target = (old / n + 1u) * n;
        XB_SPIN(xb_ld(gword) < target, bar);
        __builtin_amdgcn_fence(__ATOMIC_ACQUIRE, "agent");
        asm volatile("s_waitcnt vmcnt(0)" ::: "memory");
    }
    __syncthreads();
}
struct SchedCmp {
    int G, c;
    __device__ bool next(int i, Unit& u) const { const int L = i * G + c; if (L >= 32) return false; u.pm = L; u.pn = (L >> 1) & 1; return true; }
};
struct SchedOpt { int pm, pn; bool ok; __device__ bool next(int i, Unit& u) const { if (i || !ok) return false; u.pm = pm; u.pn = pn; return true; } };
struct SchedGrouped {
    int G, c, nct, NB; const LAS int* blk_e;
    __device__ bool next(int i, Unit& u) const { const int L = i * G + c; if (L >= NB * nct) return false; const int rb = L / nct, ct = L - rb * nct; const int v = __builtin_amdgcn_readfirstlane(blk_e[rb]); u.pm = rb; u.pn = (v & 0xffff) * nct + ct; u.aux = v >> 16; return true; }
};

struct EpiX { int fr2, fq2, pa; __device__ __forceinline__ EpiX(int fr, int fq) { const int ln = fq * 16 + fr; fr2 = ln >> 2; fq2 = ln & 3; pa = ((fq2 << 4) | fr2) << 2; }
    __device__ __forceinline__ u32x4 operator()(u32x4 w) const { u32x4 r; r.x = (unsigned)__builtin_amdgcn_ds_bpermute(pa, (int)w.x); r.y = (unsigned)__builtin_amdgcn_ds_bpermute(pa, (int)w.y);
        r.z = (unsigned)__builtin_amdgcn_ds_bpermute(pa, (int)w.z); r.w = (unsigned)__builtin_amdgcn_ds_bpermute(pa, (int)w.w); return r; } };
struct EpiWin {
    static constexpr bool PERM = true, MID = false;
    bf16* HM; bf16* CMP; bf16* CONV; bf16* MG; float* NG;
    __device__ __forceinline__ void operator()(AccRef acc, const Unit& u, int wr, int wc, int fr, int fq) const {
        const int pn = u.pn; const EpiX X(fr, fq);
#pragma unroll
        for (int ai = 0; ai < 2; ++ai)
#pragma unroll
            for (int m = 0; m < 4; ++m) {
                const int t = u.pm * 256 + ai * 128 + wr * 64 + m * 16 + ((pn < 29) ? X.fr2 : fr); const int b = t >> 12, s = t & 4095;
#pragma unroll
                for (int bj = 0; bj < 2; ++bj) {
                    const int c8 = bj * 128 + wc * 32 + ((pn < 29) ? X.fq2 : fq) * 8;
                    f32x4 v0 = acc[ai][bj][m][0], v1 = acc[ai][bj][m][1];
                    if (pn < 11) {
                        const int hh = c8 >> 6, d = c8 & 63; bf16* dst;
                        if (pn < 10) { const int head = pn * 4 + hh; const float sc = (head < 8 || (head >= 16 && head < 24)) ? QSC64 : 1.0f; v0 = v0 * sc; v1 = v1 * sc;
                            dst = HM + ((size_t)(b * NHM + head) * SEQ + s) * 64 + d; }
                        else dst = CMP + ((size_t)(b * 4 + hh) * SEQ + s) * 64 + d;
                        u32x4 w; w.x = cvt_pk_bf16(v0[0], v0[1]); w.y = cvt_pk_bf16(v0[2], v0[3]); w.z = cvt_pk_bf16(v1[0], v1[1]); w.w = cvt_pk_bf16(v1[2], v1[3]);
                        *(u32x4*)dst = X(w);
                    } else if (pn < 17) {
                        u32x4 w; w.x = cvt_pk_bf16(v0[0], v0[1]); w.y = cvt_pk_bf16(v0[2], v0[3]); w.z = cvt_pk_bf16(v1[0], v1[1]); w.w = cvt_pk_bf16(v1[2], v1[3]);
                        *(u32x4*)(CONV + (size_t)t * 1536 + (pn - 11) * 256 + c8) = X(w);
                    } else if (pn < 29) {
#pragma unroll
                        for (int j = 0; j < 4; ++j) { v0[j] = sigmoidf_(v0[j]); v1[j] = sigmoidf_(v1[j]); }
                        u32x4 w; w.x = cvt_pk_bf16(v0[0], v0[1]); w.y = cvt_pk_bf16(v0[2], v0[3]); w.z = cvt_pk_bf16(v1[0], v1[1]); w.w = cvt_pk_bf16(v1[2], v1[3]);
                        *(u32x4*)(MG + ((size_t)((u.pm * 16 + ai * 8 + wr * 4 + m) * 96 + (pn - 17) * 8 + bj * 4 + wc) * 64 + (fq * 16 + fr)) * 8) = w;
                    } else {
                        if (c8 < 24) {
#pragma unroll
                            for (int j = 0; j < 4; ++j) { v0[j] = sigmoidf_(v0[j]); v1[j] = sigmoidf_(v1[j]); }
                            *(f32x4*)(NG + (size_t)t * 24 + c8) = v0; *(f32x4*)(NG + (size_t)t * 24 + c8 + 4) = v1;
                        }
                    }
                }
            }
    }
};
struct EpiBf16 {
    static constexpr bool PERM = true, MID = false;
    bf16* O; int ldc; float scale;
    __device__ __forceinline__ void operator()(AccRef acc, const Unit& u, int wr, int wc, int fr, int fq) const {
        const EpiX X(fr, fq);
#pragma unroll
        for (int ai = 0; ai < 2; ++ai)
#pragma unroll
            for (int m = 0; m < 4; ++m) { bf16* rowp = O + (size_t)(u.pm * 256 + ai * 128 + wr * 64 + m * 16 + X.fr2) * ldc + u.pn * 256 + wc * 32 + X.fq2 * 8;
#pragma unroll
                for (int bj = 0; bj < 2; ++bj) { const f32x4 v0 = acc[ai][bj][m][0] * scale, v1 = acc[ai][bj][m][1] * scale;
                    u32x4 w; w.x = cvt_pk_bf16(v0[0], v0[1]); w.y = cvt_pk_bf16(v0[2], v0[3]); w.z = cvt_pk_bf16(v1[0], v1[1]); w.w = cvt_pk_bf16(v1[2], v1[3]);
                    *(u32x4*)(rowp + bj * 128) = X(w); } }
    }
};
struct EpiCmp1 {
    static constexpr bool PERM = true, MID = false;
    bf16* H1; const float* bias;
    __device__ __forceinline__ void operator()(AccRef acc, const Unit& u, int wr, int wc, int fr, int fq) const {
        const float* bi = bias + ((u.pm >> 1) & 1) * 256;
#pragma unroll
        for (int bj = 0; bj < 2; ++bj) { const int c8 = bj * 128 + wc * 32 + fq * 8; const f32x4 b0 = *(const f32x4*)(bi + c8), b1 = *(const f32x4*)(bi + c8 + 4);
#pragma unroll
            for (int ai = 0; ai < 2; ++ai)
#pragma unroll
                for (int m = 0; m < 4; ++m) { f32x4 v0 = acc[ai][bj][m][0] + b0, v1 = acc[ai][bj][m][1] + b1;
#pragma unroll
                    for (int j = 0; j < 4; ++j) { v0[j] = gelu_tanh(v0[j]); v1[j] = gelu_tanh(v1[j]); }
                    u32x4 w; w.x = cvt_pk_bf16(v0[0], v0[1]); w.y = cvt_pk_bf16(v0[2], v0[3]); w.z = cvt_pk_bf16(v1[0], v1[1]); w.w = cvt_pk_bf16(v1[2], v1[3]);
                    *(u32x4*)(H1 + (size_t)(u.pm * 256 + ai * 128 + wr * 64 + m * 16 + fr) * 256 + c8) = w; } }
    }
};
struct EpiCmp2 {
    static constexpr bool PERM = true, MID = false;
    bf16* CKV;
    __device__ __forceinline__ void operator()(AccRef acc, const Unit& u, int wr, int wc, int fr, int fq) const {
        if (wc < 2) {
            const int c8 = wc * 32 + fq * 8;
#pragma unroll
            for (int ai = 0; ai < 2; ++ai)
#pragma unroll
                for (int m = 0; m < 4; ++m) { const f32x4 v0 = acc[ai][0][m][0], v1 = acc[ai][0][m][1];
                    u32x4 w; w.x = cvt_pk_bf16(v0[0], v0[1]); w.y = cvt_pk_bf16(v0[2], v0[3]); w.z = cvt_pk_bf16(v1[0], v1[1]); w.w = cvt_pk_bf16(v1[2], v1[3]);
                    *(u32x4*)(CKV + ((size_t)u.pm * 256 + ai * 128 + wr * 64 + m * 16 + fr) * 64 + c8) = w; }
        }
    }
};
struct EpiMergeK {
    static constexpr bool PERM = true, MID = true;
    const bf16* MG; bf16* MERGED;
    __device__ __forceinline__ void gate8(f32x4& a, f32x4& b, int t16, int c32, int ln) const { const v4u w = *(const v4u*)(MG + ((size_t)(t16 * 96 + c32) * 64 + ln) * 8);
        a = (f32x4){bflo(w.x), bfhi(w.x), bflo(w.y), bfhi(w.y)}; b = (f32x4){bflo(w.z), bfhi(w.z), bflo(w.w), bfhi(w.w)}; }
    __device__ __forceinline__ void mid(f32x4 (&acc)[2][2][4][2], const Unit& u, int seg, int wr, int wc, int fr, int fq) const {
#pragma unroll
        for (int ai = 0; ai < 2; ++ai)
#pragma unroll
            for (int m = 0; m < 4; ++m) {
#pragma unroll
                for (int bj = 0; bj < 2; ++bj) { const unsigned ob = (unsigned)(((u.pm * 16 + ai * 8 + wr * 4 + m) * 96 + (seg - 1) * 32 + u.pn * 8 + bj * 4 + wc) * 64 + (fq * 16 + fr)) * 16u;
                    const v4u wn = *(const v4u*)((const char*)MG + ob), wd = *(const v4u*)((const char*)MG + ob + 32768u);
                    acc[ai][bj][m][0][0] *= bflo(wn.x) * __builtin_amdgcn_rcpf(bflo(wd.x)); acc[ai][bj][m][0][1] *= bfhi(wn.x) * __builtin_amdgcn_rcpf(bfhi(wd.x));
                    acc[ai][bj][m][0][2] *= bflo(wn.y) * __builtin_amdgcn_rcpf(bflo(wd.y)); acc[ai][bj][m][0][3] *= bfhi(wn.y) * __builtin_amdgcn_rcpf(bfhi(wd.y));
                    acc[ai][bj][m][1][0] *= bflo(wn.z) * __builtin_amdgcn_rcpf(bflo(wd.z)); acc[ai][bj][m][1][1] *= bfhi(wn.z) * __builtin_amdgcn_rcpf(bfhi(wd.z));
                    acc[ai][bj][m][1][2] *= bflo(wn.w) * __builtin_amdgcn_rcpf(bflo(wd.w)); acc[ai][bj][m][1][3] *= bfhi(wn.w) * __builtin_amdgcn_rcpf(bfhi(wd.w));
                    asm volatile("" ::: "memory"); } }
    }
    __device__ __forceinline__ void operator()(AccRef acc, const Unit& u, int wr, int wc, int fr, int fq) const {
        const EpiX X(fr, fq);
#pragma unroll
        for (int ai = 0; ai < 2; ++ai)
#pragma unroll
            for (int m = 0; m < 4; ++m) { const int t = u.pm * 256 + ai * 128 + wr * 64 + m * 16 + fr;
#pragma unroll
                for (int bj = 0; bj < 2; ++bj) { const int col = u.pn * 256 + bj * 128 + wc * 32 + fq * 8; f32x4 g0, g1; gate8(g0, g1, u.pm * 16 + ai * 8 + wr * 4 + m, 64 + u.pn * 8 + bj * 4 + wc, fq * 16 + fr);
                    const f32x4 v0 = acc[ai][bj][m][0] * g0, v1 = acc[ai][bj][m][1] * g1;
                    u32x4 w; w.x = cvt_pk_bf16(v0[0], v0[1]); w.y = cvt_pk_bf16(v0[2], v0[3]); w.z = cvt_pk_bf16(v1[0], v1[1]); w.w = cvt_pk_bf16(v1[2], v1[3]);
                    *(u32x4*)(MERGED + (size_t)(t - fr + X.fr2) * DM + col + (X.fq2 - fq) * 8) = X(w); }
                asm volatile("" ::: "memory"); }
    }
};
struct EpiRS {
    static constexpr bool PERM = true, MID = false;
    float* RS; bf16* HS;
    __device__ __forceinline__ void operator()(AccRef acc, const Unit& u, int wr, int wc, int fr, int fq) const {
        const EpiX X(fr, fq);
#pragma unroll
        for (int ai = 0; ai < 2; ++ai)
#pragma unroll
            for (int m = 0; m < 4; ++m) { const int t = u.pm * 256 + ai * 128 + wr * 64 + m * 16 + fr;
                if (u.pn == 0) {
#pragma unroll
                    for (int bj = 0; bj < 2; ++bj) { float* p = RS + (size_t)t * 256 + bj * 128 + wc * 32 + fq * 8; *(f32x4*)p = acc[ai][bj][m][0]; *(f32x4*)(p + 4) = acc[ai][bj][m][1]; }
                } else {
                    f32x4 h0, h1;
#pragma unroll
                    for (int j = 0; j < 4; ++j) { const float a0 = acc[ai][0][m][0][j], a1 = acc[ai][0][m][1][j]; h0[j] = a0 * sigmoidf_(a0) * acc[ai][1][m][0][j]; h1[j] = a1 * sigmoidf_(a1) * acc[ai][1][m][1][j]; }
                    u32x4 w; w.x = cvt_pk_bf16(h0[0], h0[1]); w.y = cvt_pk_bf16(h0[2], h0[3]); w.z = cvt_pk_bf16(h1[0], h1[1]); w.w = cvt_pk_bf16(h1[2], h1[3]);
                    *(u32x4*)(HS + (size_t)(t - fr + X.fr2) * 256 + (u.pn - 1) * 128 + wc * 32 + X.fq2 * 8) = X(w);
                }
            }
    }
};
struct EpiE1 {
    static constexpr bool PERM = true, MID = false;
    bf16* HE;
    __device__ __forceinline__ void operator()(AccRef acc, const Unit& u, int wr, int wc, int fr, int fq) const {
        const int ct = u.pn & 1; const EpiX X(fr, fq);
#pragma unroll
        for (int ai = 0; ai < 2; ++ai)
#pragma unroll
            for (int m = 0; m < 4; ++m) { const size_t row = (size_t)u.pm * 256 + ai * 128 + wr * 64 + m * 16 + X.fr2;
                f32x4 h0, h1;
#pragma unroll
                for (int j = 0; j < 4; ++j) { const float a0 = acc[ai][0][m][0][j], a1 = acc[ai][0][m][1][j]; h0[j] = a0 * sigmoidf_(a0) * acc[ai][1][m][0][j]; h1[j] = a1 * sigmoidf_(a1) * acc[ai][1][m][1][j]; }
                u32x4 w; w.x = cvt_pk_bf16(h0[0], h0[1]); w.y = cvt_pk_bf16(h0[2], h0[3]); w.z = cvt_pk_bf16(h1[0], h1[1]); w.w = cvt_pk_bf16(h1[2], h1[3]);
                const u32x4 wx = X(w); if (ai * 128 + wr * 64 + m * 16 + X.fr2 < u.aux) *(u32x4*)(HE + row * 256 + ct * 128 + wc * 32 + X.fq2 * 8) = wx; }
    }
};
struct EpiE2 {
    static constexpr bool PERM = true, MID = false;
    bf16* YE;
    __device__ __forceinline__ void operator()(AccRef acc, const Unit& u, int wr, int wc, int fr, int fq) const {
        const int ct = u.pn & 3; const EpiX X(fr, fq);
#pragma unroll
        for (int ai = 0; ai < 2; ++ai)
#pragma unroll
            for (int m = 0; m < 4; ++m) { const size_t row = (size_t)u.pm * 256 + ai * 128 + wr * 64 + m * 16 + X.fr2;
#pragma unroll
                for (int bj = 0; bj < 2; ++bj) { const f32x4 v0 = acc[ai][bj][m][0], v1 = acc[ai][bj][m][1];
                    u32x4 w; w.x = cvt_pk_bf16(v0[0], v0[1]); w.y = cvt_pk_bf16(v0[2], v0[3]); w.z = cvt_pk_bf16(v1[0], v1[1]); w.w = cvt_pk_bf16(v1[2], v1[3]);
                    const u32x4 wx = X(w); if (ai * 128 + wr * 64 + m * 16 + X.fr2 < u.aux) *(u32x4*)(YE + row * DM + ct * 256 + bj * 128 + wc * 32 + X.fq2 * 8) = wx; }
                asm volatile("" ::: "memory"); }
    }
};

struct Frame {
    LAS unsigned char* lds; int tid, lane, wave, vcu, G, gw, NGW; unsigned long long* tsw;
};
__device__ __forceinline__ float shx(float v, int mask, int lane) { return __builtin_bit_cast(float, __builtin_amdgcn_ds_bpermute((lane ^ mask) << 2, __builtin_bit_cast(int, v))); }
__device__ __forceinline__ int shxi(int v, int mask, int lane) { return __builtin_amdgcn_ds_bpermute((lane ^ mask) << 2, v); }
__device__ __forceinline__ float shf(float v, int src) { return __builtin_bit_cast(float, __builtin_amdgcn_ds_bpermute(src << 2, __builtin_bit_cast(int, v))); }
__device__ __forceinline__ float wave_sum(float v, int lane) {
#pragma unroll
    for (int o = 1; o < 64; o <<= 1) v += shx(v, o, lane);
    return v;
}
struct Map64Ident { __device__ int operator()(int n, int& ncv) const { ncv = 64; return n; } };
struct Map64AG { int half; __device__ int operator()(int n, int& ncv) const { ncv = 64; const int ct = n >> 8, x = n & 255; return (x < 128) ? ct * 128 + x : half + ct * 128 + (x - 128); } };
struct Map64Pad { int nsrc; __device__ int operator()(int n, int& ncv) const { ncv = (n < nsrc) ? 64 : 0; return n < nsrc ? n : 0; } };
struct Map64Win { __device__ int operator()(int n, int& ncv) const { ncv = 64;
        if (n < 2560) { const int hh = n >> 6; if (hh < 8) return hh * 64; if (hh < 16) { const int i = 2 + ((hh - 8) >> 1), g = hh & 1; return 512 + i * 128 + g * 64; } const int i = (hh - 16) >> 3, h = (hh - 16) & 7; return 1304 + i * 512 + h * 64; }
        if (n < 2816) return 512 + ((n - 2560) >> 6) * 64;
        if (n < 4352) return 2840 + (n - 2816);
        if (n < 7424) return 4376 + (n - 4352);
        if (n == 7424) { ncv = 24; return 1280; }
        ncv = 0; return 0; } };
template <class Map>
__device__ __forceinline__ void cvt_fast(Frame& F, const float* W, int lds_, int K, int Nd, bf16* WT, int pitch, const Map& cm, int nbatch, size_t sstride, size_t dstride, int gw, int ngw) {
    const int nkt = K / 64, nnt = Nd / 64, per = nkt * nnt, items = per * nbatch;
    const int n4 = F.lane & 15, kq = F.lane >> 4;
#define CVX_LOAD(R, it_) do { const int bi_ = (it_) / per, r_ = (it_) % per, kt_ = r_ / nnt, nt_ = r_ % nnt; int ncv_; const int c0_ = cm(nt_ * 64, ncv_); \
        if (n4 * 4 < ncv_) { const float* src_ = W + (size_t)bi_ * sstride + (size_t)(kt_ * 64 + kq * 16) * lds_ + c0_ + n4 * 4; _Pragma("unroll") for (int i_ = 0; i_ < 16; ++i_) R[i_] = *(const f32x4*)(src_ + (size_t)i_ * lds_); } \
        else { _Pragma("unroll") for (int i_ = 0; i_ < 16; ++i_) R[i_] = (f32x4){0.f, 0.f, 0.f, 0.f}; } } while (0)
#define CVX_STORE(R, it_) do { const int bi_ = (it_) / per, r_ = (it_) % per, kt_ = r_ / nnt, nt_ = r_ % nnt; \
          \
        _Pragma("unroll") for (int c_ = 0; c_ < 4; ++c_) _Pragma("unroll") for (int h_ = 0; h_ < 2; ++h_) { v4u o_; \
            o_.x = cvt_pk_bf16(R[8 * h_ + 0][c_], R[8 * h_ + 1][c_]); o_.y = cvt_pk_bf16(R[8 * h_ + 2][c_], R[8 * h_ + 3][c_]); o_.z = cvt_pk_bf16(R[8 * h_ + 4][c_], R[8 * h_ + 5][c_]); o_.w = cvt_pk_bf16(R[8 * h_ + 6][c_], R[8 * h_ + 7][c_]); \
            *(LAS v4u*)(stg + (n4 * 4 + c_) * 128 + (((2 * kq + h_) ^ (n4 & 7)) * 16)) = o_; } \
        bf16* dst_ = WT + (size_t)bi_ * dstride + (size_t)(nt_ * 64 + (F.lane >> 3)) * pitch + kt_ * 64 + (F.lane & 7) * 8; \
        _Pragma("unroll") for (int j_ = 0; j_ < 8; ++j_) { const int rr_ = j_ * 8 + (F.lane >> 3); \
            const v4u v_ = *(const LAS v4u*)(stg + rr_ * 128 + ((((F.lane & 7) ^ ((rr_ >> 2) & 7))) * 16)); *(v4u*)(dst_ + (size_t)(j_ * 8) * pitch) = v_; } } while (0)
    LAS char* const stg = (LAS char*)F.lds + F.wave * 8192;
    f32x4 ra[16], rb[16], rc[16];
    for (int it = gw; it < items; it += 3 * ngw) {
        const int itB = it + ngw, itC = it + 2 * ngw; const bool hasB = itB < items, hasC = itC < items;
        CVX_LOAD(ra, it);
        if (hasB) CVX_LOAD(rb, itB);
        if (hasC) CVX_LOAD(rc, itC);
        CVX_STORE(ra, it);
        if (hasB) CVX_STORE(rb, itB);
        if (hasC) CVX_STORE(rc, itC);
    }
#undef CVX_LOAD
#undef CVX_STORE
}

template <bool GATHER>
__device__ __forceinline__ void ln_phase(Frame& F, const bf16* res, const bf16* delta, const bf16* ye, const int* pos, const float* rwt, const float* gam, const float* bet, float* outf, bf16* outb, float oscale = 1.0f) {
    const int lane = F.lane;
    f32x4 gv[4], bv[4];
    if (!GATHER) {
#pragma unroll
        for (int j = 0; j < 4; ++j) { gv[j] = *((const f32x4*)gam + lane + 64 * j); bv[j] = *((const f32x4*)bet + lane + 64 * j); } }
    v2u rr[4]; v2u dd[4]; v2u yy[GATHER ? 8 : 1][4]; float ww[GATHER ? 8 : 1];
#define LN_REQ(row_) do { const size_t ro_ = (size_t)(row_) * DM; _Pragma("unroll") for (int j_ = 0; j_ < 4; ++j_) { rr[j_] = *((const v2u*)(res + ro_) + lane + 64 * j_); dd[j_] = *((const v2u*)(delta + ro_) + lane + 64 * j_); } \
        if (GATHER) { _Pragma("unroll") for (int k_ = 0; k_ < 8; ++k_) { const bf16* yr_ = ye + (size_t)pos[(size_t)(row_) * 8 + k_] * DM; ww[k_] = rwt[(size_t)(row_) * 8 + k_]; \
            _Pragma("unroll") for (int j_ = 0; j_ < 4; ++j_) yy[k_][j_] = *((const v2u*)yr_ + lane + 64 * j_); } } } while (0)
    const bool grp = (F.G == 256);
    int r = grp ? (F.vcu >> 5) * SEQ + (F.vcu & 31) * NWAVES + F.wave : F.gw;
    const int rstep = grp ? 32 * NWAVES : F.NGW, rend = grp ? ((F.vcu >> 5) + 1) * SEQ : T;
    if (r < rend) LN_REQ(r);
    for (; r < rend; r += rstep) {
        f32x4 v[4];
#pragma unroll
        for (int j = 0; j < 4; ++j) { const f32x4 d = (f32x4){bflo(dd[j].x), bfhi(dd[j].x), bflo(dd[j].y), bfhi(dd[j].y)}, rf = (f32x4){bflo(rr[j].x), bfhi(rr[j].x), bflo(rr[j].y), bfhi(rr[j].y)}; v[j] = rf * DN_ALPHA + d; }
        if (GATHER) {
#pragma unroll
            for (int k = 0; k < 8; ++k)
#pragma unroll
                for (int j = 0; j < 4; ++j) { v[j][0] += ww[k] * bflo(yy[k][j].x); v[j][1] += ww[k] * bfhi(yy[k][j].x); v[j][2] += ww[k] * bflo(yy[k][j].y); v[j][3] += ww[k] * bfhi(yy[k][j].y); } }
        if (r + rstep < rend) LN_REQ(r + rstep);
        float s = 0.f;
#pragma unroll
        for (int j = 0; j < 4; ++j) s += (v[j][0] + v[j][1]) + (v[j][2] + v[j][3]);
        const float mean = wave_sum(s, lane) * (1.f / DM); float s2 = 0.f;
#pragma unroll
        for (int j = 0; j < 4; ++j) { v[j] = v[j] - mean; s2 += (v[j][0] * v[j][0] + v[j][1] * v[j][1]) + (v[j][2] * v[j][2] + v[j][3] * v[j][3]); }
        const float rstd = 1.f / sqrtf(wave_sum(s2, lane) * (1.f / DM) + LN_EPS);
#pragma unroll
        for (int j = 0; j < 4; ++j) { if (GATHER) { gv[j] = *((const f32x4*)gam + lane + 64 * j); bv[j] = *((const f32x4*)bet + lane + 64 * j); } const f32x4 o = (v[j] * rstd * gv[j] + bv[j]) * oscale;
            if (outf) *((f32x4*)(outf + (size_t)r * DM) + lane + 64 * j) = o;
            if (outb) { v2u w; w.x = cvt_pk_bf16(o[0], o[1]); w.y = cvt_pk_bf16(o[2], o[3]); *((v2u*)(outb + (size_t)r * DM) + lane + 64 * j) = w; } }
    }
#undef LN_REQ
}

constexpr int AT_K = 0  , AT_V = 33792  , AT_WS = 66560, AT_OST = 68608  , AT_IMP = AT_OST  ,
              AT_MASK = LDSCTL_OFF + 1024, AT_TL = LDSCTL_OFF + 3072, AT_KM = LDSCTL_OFF + 4096;
__device__ __forceinline__ void lds_fadd(LAS float* p, float v) { (void)__hip_atomic_fetch_add(p, v, __ATOMIC_RELAXED, __HIP_MEMORY_SCOPE_WORKGROUP); }
__device__ __forceinline__ void lds_or(LAS unsigned* p, unsigned v) { (void)__hip_atomic_fetch_or(p, v, __ATOMIC_RELAXED, __HIP_MEMORY_SCOPE_WORKGROUP); }
__device__ __forceinline__ int opq(int v) { asm volatile("" : "+v"(v)); return v; }
__device__ __forceinline__ int crow(int r, int hi) { return (r & 3) + 8 * (r >> 2) + 4 * hi; }
__device__ __forceinline__ float pswap_max(float m) { auto rr = __builtin_amdgcn_permlane32_swap(__float_as_uint(m), __float_as_uint(m), false, false); return fmaxf(__uint_as_float(rr[0]), __uint_as_float(rr[1])); }
__device__ __forceinline__ float pswap_sum(float m) { auto rr = __builtin_amdgcn_permlane32_swap(__float_as_uint(m), __float_as_uint(m), false, false); return __uint_as_float(rr[0]) + __uint_as_float(rr[1]); }
__device__ __forceinline__ s16x4 vtr(const LAS char* p) { return __builtin_bit_cast(s16x4, __builtin_amdgcn_ds_read_tr16_b64_v4i16((LAS s16x4*)p)); }

template <int D> struct AttnSt {
    f32x16 o[D / 32]; f32x16 ls;
    float l;
    float m; bool fresh;
    v4u qb;
    bf16x8 qr[D / 16];
};
template <int D, bool WITH_V>
__device__ __forceinline__ void at_load(v4u (&kr)[D / 64], v4u (&vr)[D / 64], const bf16* Kg, const bf16* Vg, int pitch, int kv0, int wid, int lane) {
#pragma unroll
    for (int i = 0; i < D / 64; ++i) { const int pi = wid + 8 * i;
        kr[i] = *(const v4u*)(Kg + (size_t)(kv0 + (8 * i + wid) * (512 / D) + lane / (D / 8)) * pitch + (lane % (D / 8)) * 8);
        if (WITH_V) { const int dblk = pi >> 2, rg = pi & 3; vr[i] = *(const v4u*)(Vg + (size_t)(kv0 + 16 * rg + (lane >> 2)) * pitch + dblk * 32 + (lane & 3) * 8); } }
}
__device__ __forceinline__ void at_vdma64(const bf16* Vg, int pitch, int kv0, LAS char* Vs, int wid, int lane) {
    const int dblk = wid >> 2, rg = wid & 3;
    __builtin_amdgcn_global_load_lds((const unsigned*)(Vg + (size_t)(kv0 + 16 * rg + (lane >> 2)) * pitch + dblk * 32 + (lane & 3) * 8), (LAS unsigned*)(Vs + wid * 1024), 16, 0, 0);
}
__device__ __forceinline__ void at_kdma64(const bf16* Kg, int pitch, int kv0, LAS char* Ks, int wid, int lane) {
    __builtin_amdgcn_global_load_lds((const unsigned*)(Kg + (size_t)(kv0 + lane) * pitch + wid * 8), (LAS unsigned*)(Ks + wid * 1040), 16, 0, 0);
}
template <int D, bool WITH_V>
__device__ __forceinline__ void at_store(const v4u (&kr)[D / 64], const v4u (&vr)[D / 64], LAS char* Ks, LAS char* Vs, int wid, int lane) {
#pragma unroll
    for (int i = 0; i < D / 64; ++i) { const int pi = wid + 8 * i;
        *(LAS v4u*)(Ks + (lane % (D / 8)) * 1040 + ((8 * i + wid) * (512 / D) + lane / (D / 8)) * 16) = kr[i];
        if (WITH_V) *(LAS v4u*)(Vs + pi * 1024 + lane * 16) = vr[i]; }
}
template <int D, bool INIT = false>
__device__ __forceinline__ void at_qk(f32x16& p0, f32x16& p1, const LAS char* Ks, const bf16x8 (&qr)[D / 16], int r32, int hi) {
    const LAS char* kb = Ks + hi * 1040 + r32 * 16;
    if (!INIT) { p0 = f32x16{}; p1 = f32x16{}; }
    bf16x8 ka = *(const LAS bf16x8*)(kb), kc = *(const LAS bf16x8*)(kb + 512);
#pragma unroll
    for (int d0 = 0; d0 < D / 16; ++d0) {
        bf16x8 na = ka, nc = kc;
        if (d0 + 1 < D / 16) { na = *(const LAS bf16x8*)(kb + (d0 + 1) * 2080); nc = *(const LAS bf16x8*)(kb + (d0 + 1) * 2080 + 512); }
        p0 = __builtin_amdgcn_mfma_f32_32x32x16_bf16(ka, qr[d0], p0, 0, 0, 0);
        p1 = __builtin_amdgcn_mfma_f32_32x32x16_bf16(kc, qr[d0], p1, 0, 0, 0);
        __builtin_amdgcn_sched_barrier(0);
        ka = na; kc = nc;
    }
}
template <int D>
__device__ __forceinline__ void at_pv(f32x16 (&o)[D / 32], const f32x16& p0, const f32x16& p1, const LAS char* Vs, int lane, int hi, bool rowmask = false, bool keep = true, f32x16* ls = nullptr) {
    bf16x8 pa[4];
#pragma unroll
    for (int ks = 0; ks < 4; ++ks) { const f32x16& P = (ks < 2) ? p0 : p1; const int b = (ks & 1) * 8;
        v4u w; w.x = cvt_pk_bf16(P[b + 0], P[b + 1]); w.y = cvt_pk_bf16(P[b + 2], P[b + 3]); w.z = cvt_pk_bf16(P[b + 4], P[b + 5]); w.w = cvt_pk_bf16(P[b + 6], P[b + 7]);
        if (rowmask) { w.x = keep ? w.x : 0u; w.y = keep ? w.y : 0u; w.z = keep ? w.z : 0u; w.w = keep ? w.w : 0u; }
        pa[ks] = __builtin_bit_cast(bf16x8, w); }
    const LAS char* vp = Vs + ((lane >> 4) & 1) * 32 + (lane & 3) * 8 + (4 * hi + ((lane & 15) >> 2)) * 64;
    if (ls) { const v4u one4 = (v4u){0x3F803F80u, 0x3F803F80u, 0x3F803F80u, 0x3F803F80u}; const bf16x8 ones = __builtin_bit_cast(bf16x8, one4);
#pragma unroll
        for (int ks = 0; ks < 4; ++ks) *ls = __builtin_amdgcn_mfma_f32_32x32x16_bf16(pa[ks], ones, *ls, 0, 0, 0); }
    constexpr int ND = D / 32;
    s16x4 lo[ND], hh[ND];
#pragma unroll
    for (int dd = 0; dd < ND; ++dd) { lo[dd] = vtr(vp + dd * 4096); hh[dd] = vtr(vp + dd * 4096 + 512); }
#pragma unroll
    for (int ks = 0; ks < 4; ++ks) {
        s16x4 nlo[ND], nhh[ND];
#pragma unroll
        for (int dd = 0; dd < ND; ++dd) { nlo[dd] = lo[dd]; nhh[dd] = hh[dd]; if (ks + 1 < 4) { nlo[dd] = vtr(vp + dd * 4096 + (ks + 1) * 1024); nhh[dd] = vtr(vp + dd * 4096 + (ks + 1) * 1024 + 512); } }
#pragma unroll
        for (int dd = 0; dd < ND; ++dd) { const bf16x8 vb = (bf16x8){lo[dd][0], lo[dd][1], lo[dd][2], lo[dd][3], hh[dd][0], hh[dd][1], hh[dd][2], hh[dd][3]};
            o[dd] = __builtin_amdgcn_mfma_f32_32x32x16_bf16(pa[ks], vb, o[dd], 0, 0, 0); }
        __builtin_amdgcn_sched_barrier(0);
#pragma unroll
        for (int dd = 0; dd < ND; ++dd) { lo[dd] = nlo[dd]; hh[dd] = nhh[dd]; }
    }
}
__device__ __forceinline__ float max3f(float a, float b, float c) { return __builtin_fmaxf(__builtin_fmaxf(a, b), c); }
__device__ __forceinline__ float max32(const f32x16& p0, const f32x16& p1) {
    float a = max3f(p0[0], p0[1], p1[0]), b = max3f(p0[2], p0[3], p1[1]);
    a = max3f(a, p1[2], p1[3]);
#pragma unroll
    for (int r = 4; r < 16; r += 4) { a = max3f(a, p0[r], p0[r + 1]); b = max3f(b, p0[r + 2], p0[r + 3]); a = max3f(a, p1[r], p1[r + 1]); b = max3f(b, p1[r + 2], p1[r + 3]); }
    return __builtin_fmaxf(a, b);
}
template <int ND>
__device__ __forceinline__ void at_scale_rows(f32x16 (&o)[ND], f32x16& ls, float f, LAS float* wsf, int r32, int hi) {
    if (hi == 0) wsf[r32] = f;
    LDS_WAIT();
#pragma unroll
    for (int g = 0; g < 4; ++g) { const f32x4 fv = *(const LAS f32x4*)(wsf + 8 * g + 4 * hi);
#pragma unroll
        for (int d = 0; d < ND; ++d) { o[d][4 * g + 0] *= fv[0]; o[d][4 * g + 1] *= fv[1]; o[d][4 * g + 2] *= fv[2]; o[d][4 * g + 3] *= fv[3]; }
        ls[4 * g + 0] *= fv[0]; ls[4 * g + 1] *= fv[1]; ls[4 * g + 2] *= fv[2]; ls[4 * g + 3] *= fv[3]; }
    LDS_WAIT();
}
template <int ND>
__device__ __forceinline__ void at_normalize(f32x16 (&o)[ND], const f32x16& ls) {
#pragma unroll
    for (int r = 0; r < 16; ++r) { const float inv = __builtin_amdgcn_rcpf(ls[r]);
#pragma unroll
        for (int d = 0; d < ND; ++d) o[d][r] *= inv; }
}
constexpr float AT_THR = 4.0f;
constexpr int AT_SKEW = 0;
__device__ __forceinline__ void at_set_negm(v4u& qb, float m, int hi) {
    const float nm = -m; const float m1 = __uint_as_float(__float_as_uint(nm) & 0xffff0000u), r1 = nm - m1, m2 = __uint_as_float(__float_as_uint(r1) & 0xffff0000u), r2 = r1 - m2, m3 = __uint_as_float(__float_as_uint(r2) & 0xffff0000u);
    const unsigned w0 = (__float_as_uint(m1) >> 16) | (__float_as_uint(m2) & 0xffff0000u), w1 = __float_as_uint(m3) >> 16;
    qb.x = hi ? w0 : qb.x; qb.y = hi ? w1 : qb.y;
}
template <int D>
__device__ __forceinline__ void at_std_tile(AttnSt<D>& st, f32x16& p0, f32x16& p1, const LAS char* Vs, int lim_hi, int lim_lo, int mask_mode, bool rowact,
                                            LAS float* wsf, int lane, int r32, int hi) {
    if (mask_mode == 2) {
#pragma unroll
        for (int r = 0; r < 16; ++r) { const int pl = (r & 3) + 8 * (r >> 2) + 4 * hi;
            p0[r] = (pl <= lim_hi && pl >= lim_lo) ? p0[r] : -INFINITY; p1[r] = (pl + 32 <= lim_hi && pl + 32 >= lim_lo) ? p1[r] : -INFINITY; }
    }
    float rm = pswap_max(max32(p0, p1));
    if (mask_mode == 1) rm = rowact ? rm : -INFINITY;
    const bool need = st.fresh ? (rm > -INFINITY) : (rm > AT_THR);
    if (__any(need)) {
        const float dl = need ? rm : 0.f;
        const float al = (need && !st.fresh) ? __builtin_amdgcn_exp2f(-dl) : 1.0f;
#pragma unroll
        for (int r = 0; r < 16; ++r) { p0[r] -= dl; p1[r] -= dl; }
        st.m += dl; st.fresh = st.fresh && !need;
        at_set_negm(st.qb, st.m, hi); st.l *= al;
        at_scale_rows<D / 32>(st.o, st.ls, al, wsf, r32, hi);
    }
#pragma unroll
    for (int r = 0; r < 16; ++r) { p0[r] = __builtin_amdgcn_exp2f(p0[r]); p1[r] = __builtin_amdgcn_exp2f(p1[r]); }
    if constexpr (D == 64) at_pv<D>(st.o, p0, p1, Vs, lane, hi, mask_mode == 1, rowact, &st.ls);
    else { float sum = 0.f;
#pragma unroll
        for (int r = 0; r < 16; ++r) { sum += p0[r]; sum += p1[r]; }
        if (mask_mode == 1) sum = rowact ? sum : 0.f;
        st.l += sum;
        at_pv<D>(st.o, p0, p1, Vs, lane, hi, mask_mode == 1, rowact, nullptr); }
}
template <int D, bool ALIBI = true>
__device__ __forceinline__ void at_std_pass1(AttnSt<D>& st, LAS unsigned char* lds, const bf16* Kg, const bf16* Vg, int pitch, const LAS int* tl, int ntile,
                                            int t, unsigned long long bits, int W, float sl2, int wid, int lane) {
    lane = opq(lane); const int r32 = lane & 31, hi = lane >> 5;
    const unsigned almask = hi ? 0u : 0xffffu;
    const unsigned alb0 = hi ? 0u : ((__float_as_uint((float)r32) >> 16) << 16), alb1 = hi ? 0u : ((__float_as_uint((float)(r32 + 32)) >> 16) << 16);
    { const float s1f = __uint_as_float(__float_as_uint(sl2) & 0xffff0000u), r1 = sl2 - s1f, s2f = __uint_as_float(__float_as_uint(r1) & 0xffff0000u), r2 = r1 - s2f, s3f = __uint_as_float(__float_as_uint(r2) & 0xffff0000u);
      const unsigned b1 = __float_as_uint(s1f) >> 16, b2 = __float_as_uint(s2f) >> 16, b3 = __float_as_uint(s3f) >> 16;
      st.qb.x = hi ? 0u : (b1 | (b2 << 16)); st.qb.y = hi ? 0u : (b3 | (b1 << 16)); st.qb.z = hi ? 0u : (b2 | (b3 << 16)); st.qb.w = 0u; }
    LAS float* wsf = (LAS float*)(lds + AT_WS) + wid * 64;
    constexpr int SLOT = 64 * D * 2, KSLOT = 130 * D;
    v4u kr[D / 64], vr[D / 64];
#pragma unroll
    for (int d = 0; d < D / 32; ++d) st.o[d] = f32x16{};
    st.ls = f32x16{}; st.l = 0.f; st.m = 0.f; st.fresh = true;
    if (ntile <= 0) return;
    at_load<D, true>(kr, vr, Kg, Vg, pitch, __builtin_amdgcn_readfirstlane(tl[0]) * 64, wid, lane);
    at_store<D, true>(kr, vr, (LAS char*)lds + AT_K, (LAS char*)lds + AT_V, wid, lane);
    __syncthreads();
    for (int it = 0; it < ntile; ++it) {
        const int cur = it & 1; const int kt = __builtin_amdgcn_readfirstlane(tl[it]);
        if (it + 1 < ntile) at_load<D, true>(kr, vr, Kg, Vg, pitch, __builtin_amdgcn_readfirstlane(tl[it + 1]) * 64, wid, lane);
        const LAS char* Ks = (const LAS char*)lds + AT_K + cur * KSLOT; const LAS char* Vs = (const LAS char*)lds + AT_V + cur * SLOT;
        const int kvbase = kt * 64;
        const bool rowok = (bits >> kt) & 1ull;
        const int lim_hi = rowok ? (t - kvbase) : -1, lim_lo = t - W + 1 - kvbase;
        const bool active = (lim_hi >= 0) && (lim_lo <= 63) && (lim_lo <= lim_hi);
        if (__any(active)) {
            const bool full = (lim_hi >= 63 && lim_lo <= 0);
            const int mask_mode = __any(active && !full) ? 2 : (__any(!active) ? 1 : 0);
            f32x16 p0, p1;
            {
                const unsigned a16 = ALIBI ? (unsigned)__builtin_amdgcn_readfirstlane((int)(__float_as_uint((float)kvbase) >> 16)) : 0u;
                v4u ka; ka.x = hi ? 0x3F803F80u : (a16 * 0x10001u); ka.y = hi ? 0x3F80u : ((a16 & almask) | alb0); ka.z = alb0 | (alb0 >> 16); ka.w = 0u;
                v4u kb2 = ka; kb2.y = hi ? 0x3F80u : ((a16 & almask) | alb1); kb2.z = alb1 | (alb1 >> 16);
                const bf16x8 qbv = __builtin_bit_cast(bf16x8, st.qb);
                at_qk<D, false>(p0, p1, Ks, st.qr, r32, hi);
                p0 = __builtin_amdgcn_mfma_f32_32x32x16_bf16(__builtin_bit_cast(bf16x8, ka), qbv, p0, 0, 0, 0);
                p1 = __builtin_amdgcn_mfma_f32_32x32x16_bf16(__builtin_bit_cast(bf16x8, kb2), qbv, p1, 0, 0, 0);
            }
            at_std_tile<D>(st, p0, p1, Vs, lim_hi, lim_lo, mask_mode, active, wsf, lane, r32, hi);
        }
        if (it + 1 < ntile) at_store<D, true>(kr, vr, (LAS char*)lds + AT_K + (cur ^ 1) * KSLOT, (LAS char*)lds + AT_V + (cur ^ 1) * SLOT, wid, lane);
        __syncthreads();
    }
}
constexpr int AT_V8 = 8 * 8320, AT_WS8 = AT_V8 + 8 * 8192;
static_assert(AT_WS8 + 2048 <= LDSCTL_OFF, "8-slot rings overflow the phase scratch");
template <int D, bool ALIBI = true, bool RING8 = false>
__device__ __forceinline__ void at_std_pass(AttnSt<D>& st, LAS unsigned char* lds, const bf16* Kg, const bf16* Vg, int pitch, const LAS int* tl, int ntile,
                                            int t, unsigned long long bits, int W, float sl2, int wid, int lane) {
    lane = opq(lane); const int r32 = lane & 31, hi = lane >> 5;
    const unsigned almask = hi ? 0u : 0xffffu;
    const unsigned alb0 = hi ? 0u : ((__float_as_uint((float)r32) >> 16) << 16), alb1 = hi ? 0u : ((__float_as_uint((float)(r32 + 32)) >> 16) << 16);
    { const float s1f = __uint_as_float(__float_as_uint(sl2) & 0xffff0000u), r1 = sl2 - s1f, s2f = __uint_as_float(__float_as_uint(r1) & 0xffff0000u), r2 = r1 - s2f, s3f = __uint_as_float(__float_as_uint(r2) & 0xffff0000u);
      const unsigned b1 = __float_as_uint(s1f) >> 16, b2 = __float_as_uint(s2f) >> 16, b3 = __float_as_uint(s3f) >> 16;
      st.qb.x = hi ? 0u : (b1 | (b2 << 16)); st.qb.y = hi ? 0u : (b3 | (b1 << 16)); st.qb.z = hi ? 0u : (b2 | (b3 << 16)); st.qb.w = 0u; }
    LAS float* wsf = (LAS float*)(lds + (RING8 ? AT_WS8 : AT_WS)) + wid * 64;
    constexpr int SLOT = 64 * D * 2, KSLOT = 130 * D;
    v4u kr[D / 64], vr[D / 64];
#pragma unroll
    for (int d = 0; d < D / 32; ++d) st.o[d] = f32x16{};
    st.ls = f32x16{}; st.l = 0.f; st.m = 0.f; st.fresh = true;
    if (ntile <= 0) return;
#define TSQ() do {} while (0)
#define AT_TILE(kt_, Ks_, Vs_) do { const int kvbase = (kt_) * 64; const bool rowok = (bits >> (kt_)) & 1ull; \
        const int lim_hi = rowok ? (t - kvbase) : -1, lim_lo = t - W + 1 - kvbase; const bool active = (lim_hi >= 0) && (lim_lo <= 63) && (lim_lo <= lim_hi); \
        if (__any(active)) { const bool full = (lim_hi >= 63 && lim_lo <= 0); const int mask_mode = __any(active && !full) ? 2 : (__any(!active) ? 1 : 0); \
            f32x16 p0, p1; \
            const unsigned a16 = ALIBI ? (unsigned)__builtin_amdgcn_readfirstlane((int)(__float_as_uint((float)kvbase) >> 16)) : 0u; \
            v4u ka; ka.x = hi ? 0x3F803F80u : (a16 * 0x10001u); ka.y = hi ? 0x3F80u : ((a16 & almask) | alb0); ka.z = alb0 | (alb0 >> 16); ka.w = 0u; \
            v4u kb2 = ka; kb2.y = hi ? 0x3F80u : ((a16 & almask) | alb1); kb2.z = alb1 | (alb1 >> 16); \
            const bf16x8 qbv = __builtin_bit_cast(bf16x8, st.qb); \
            TSQ(); \
            at_qk<D, false>(p0, p1, (Ks_), st.qr, r32, hi); \
            p0 = __builtin_amdgcn_mfma_f32_32x32x16_bf16(__builtin_bit_cast(bf16x8, ka), qbv, p0, 0, 0, 0); \
            p1 = __builtin_amdgcn_mfma_f32_32x32x16_bf16(__builtin_bit_cast(bf16x8, kb2), qbv, p1, 0, 0, 0); \
            at_std_tile<D>(st, p0, p1, (Vs_), lim_hi, lim_lo, mask_mode, active, wsf, lane, r32, hi); } } while (0)
    if constexpr (RING8) {
        static_assert(D == 64, "RING8 is the D = 64 layout");
        v4u kr2[1], vr2[1];
        const int npair = (ntile + 1) >> 1;
#define TLX(i_) (((i_) < ntile) ? __builtin_amdgcn_readfirstlane(tl[(i_)]) : 0)
        int c0 = TLX(0), c1 = TLX(1), d0 = TLX(2), d1 = TLX(3), e0 = TLX(4), e1 = TLX(5);
        at_kdma64(Kg, pitch, c0 * 64, (LAS char*)lds + AT_K, wid, lane); at_vdma64(Vg, pitch, c0 * 64, (LAS char*)lds + AT_V8, wid, lane);
        if (ntile > 1) { at_kdma64(Kg, pitch, c1 * 64, (LAS char*)lds + AT_K + KSLOT, wid, lane); at_vdma64(Vg, pitch, c1 * 64, (LAS char*)lds + AT_V8 + SLOT, wid, lane); }
        if (ntile > 2) { at_kdma64(Kg, pitch, d0 * 64, (LAS char*)lds + AT_K + 2 * KSLOT, wid, lane); at_vdma64(Vg, pitch, d0 * 64, (LAS char*)lds + AT_V8 + 2 * SLOT, wid, lane);
            if (ntile > 3) { at_kdma64(Kg, pitch, d1 * 64, (LAS char*)lds + AT_K + 3 * KSLOT, wid, lane); at_vdma64(Vg, pitch, d1 * 64, (LAS char*)lds + AT_V8 + 3 * SLOT, wid, lane); } }
        __syncthreads();
        for (int p = 0; p < npair; ++p) {
            const int s0 = (p & 3) * 2, s2 = ((p + 2) & 3) * 2; const int i0 = 2 * p, i1 = 2 * p + 1;
            const bool n0 = (i0 + 4 < ntile), n1 = (i1 + 4 < ntile);
            if (n0) { at_kdma64(Kg, pitch, e0 * 64, (LAS char*)lds + AT_K + s2 * KSLOT, wid, lane); at_vdma64(Vg, pitch, e0 * 64, (LAS char*)lds + AT_V8 + s2 * SLOT, wid, lane); }
            if (n1) { at_kdma64(Kg, pitch, e1 * 64, (LAS char*)lds + AT_K + (s2 + 1) * KSLOT, wid, lane); at_vdma64(Vg, pitch, e1 * 64, (LAS char*)lds + AT_V8 + (s2 + 1) * SLOT, wid, lane); }
            const int q0 = (i0 + 6 < ntile) ? tl[i0 + 6] : 0, q1 = (i1 + 6 < ntile) ? tl[i1 + 6] : 0;
            AT_TILE(c0, (const LAS char*)lds + AT_K + s0 * KSLOT, (const LAS char*)lds + AT_V8 + s0 * SLOT);
            __builtin_amdgcn_sched_barrier(0);
            if (i1 < ntile) AT_TILE(c1, (const LAS char*)lds + AT_K + (s0 + 1) * KSLOT, (const LAS char*)lds + AT_V8 + (s0 + 1) * SLOT);
            __builtin_amdgcn_sched_barrier(0);
            c0 = d0; c1 = d1; d0 = e0; d1 = e1; e0 = __builtin_amdgcn_readfirstlane(q0); e1 = __builtin_amdgcn_readfirstlane(q1);
            if ((p & 1) || p + 1 == npair) __syncthreads();
        }
#undef TLX
    } else if constexpr (D == 64) {
        v4u kr2[1], vr2[1];
        const int npair = (ntile + 1) >> 1;
        { const int t0_ = __builtin_amdgcn_readfirstlane(tl[0]) * 64; at_kdma64(Kg, pitch, t0_, (LAS char*)lds + AT_K, wid, lane); at_vdma64(Vg, pitch, t0_, (LAS char*)lds + AT_V, wid, lane); }
        if (ntile > 1) { const int t1_ = __builtin_amdgcn_readfirstlane(tl[1]) * 64; at_kdma64(Kg, pitch, t1_, (LAS char*)lds + AT_K + KSLOT, wid, lane); at_vdma64(Vg, pitch, t1_, (LAS char*)lds + AT_V + SLOT, wid, lane); }
        __syncthreads();
#define TS(x) do {} while (0)
        int kt0 = __builtin_amdgcn_readfirstlane(tl[0]), kt1 = (ntile > 1) ? __builtin_amdgcn_readfirstlane(tl[1]) : 0;
        int nk0 = (ntile > 2) ? __builtin_amdgcn_readfirstlane(tl[2]) : 0, nk1 = (ntile > 3) ? __builtin_amdgcn_readfirstlane(tl[3]) : 0;
        for (int p = 0; p < npair; ++p) {
            TS(tA);
            const int s0 = (p & 1) * 2; const int i0 = 2 * p, i1 = 2 * p + 1;
            const bool n0 = (i0 + 2 < ntile), n1 = (i1 + 2 < ntile);
            if (n0) { at_kdma64(Kg, pitch, nk0 * 64, (LAS char*)lds + AT_K + (s0 ^ 2) * KSLOT, wid, lane); at_vdma64(Vg, pitch, nk0 * 64, (LAS char*)lds + AT_V + (s0 ^ 2) * SLOT, wid, lane); }
            if (n1) { at_kdma64(Kg, pitch, nk1 * 64, (LAS char*)lds + AT_K + ((s0 ^ 2) + 1) * KSLOT, wid, lane); at_vdma64(Vg, pitch, nk1 * 64, (LAS char*)lds + AT_V + ((s0 ^ 2) + 1) * SLOT, wid, lane); }
            const int q0 = (i0 + 4 < ntile) ? tl[i0 + 4] : 0, q1 = (i1 + 4 < ntile) ? tl[i1 + 4] : 0;
            if (AT_SKEW > 0 && wid >= 4) __builtin_amdgcn_s_sleep(AT_SKEW);
            TS(tB);
            AT_TILE(kt0, (const LAS char*)lds + AT_K + s0 * KSLOT, (const LAS char*)lds + AT_V + s0 * SLOT);
            __builtin_amdgcn_sched_barrier(0);
            if (i1 < ntile) AT_TILE(kt1, (const LAS char*)lds + AT_K + (s0 + 1) * KSLOT, (const LAS char*)lds + AT_V + (s0 + 1) * SLOT);
            __builtin_amdgcn_sched_barrier(0);
            TS(tC);
            const int s1 = s0 ^ 2;
            kt0 = nk0; kt1 = nk1; nk0 = __builtin_amdgcn_readfirstlane(q0); nk1 = __builtin_amdgcn_readfirstlane(q1);
            TS(tD);
            __syncthreads();
            TS(tE);
        }
    } else {
        at_load<D, true>(kr, vr, Kg, Vg, pitch, __builtin_amdgcn_readfirstlane(tl[0]) * 64, wid, lane);
        at_store<D, true>(kr, vr, (LAS char*)lds + AT_K, (LAS char*)lds + AT_V, wid, lane);
        __syncthreads();
        for (int it = 0; it < ntile; ++it) {
            const int cur = it & 1; const int kt = __builtin_amdgcn_readfirstlane(tl[it]);
            if (it + 1 < ntile) at_load<D, true>(kr, vr, Kg, Vg, pitch, __builtin_amdgcn_readfirstlane(tl[it + 1]) * 64, wid, lane);
            AT_TILE(kt, (const LAS char*)lds + AT_K + cur * KSLOT, (const LAS char*)lds + AT_V + cur * SLOT);
            if (it + 1 < ntile) at_store<D, true>(kr, vr, (LAS char*)lds + AT_K + (cur ^ 1) * KSLOT, (LAS char*)lds + AT_V + (cur ^ 1) * SLOT, wid, lane);
            __syncthreads();
        }
    }
#undef AT_TILE
}
__device__ __forceinline__ void at_pass_resident128(AttnSt<128>& st, LAS unsigned char* lds, const bf16* Kg, const bf16* Vg, int pitch, int nt, int wid, int lane) {
    lane = opq(lane); const int r32 = lane & 31, hi = lane >> 5;
    st.qb = (v4u){0u, 0u, 0u, 0u};
    LAS float* wsf = (LAS float*)(lds + AT_WS8) + wid * 64;
#pragma unroll
    for (int d = 0; d < 4; ++d) st.o[d] = f32x16{};
    st.ls = f32x16{}; st.l = 0.f; st.m = 0.f; st.fresh = true;
    for (int kt = 0; kt < nt; ++kt) {
#pragma unroll
        for (int i = 0; i < 2; ++i) { const int pi = wid + 8 * i;
            __builtin_amdgcn_global_load_lds((const unsigned*)(Kg + (size_t)(kt * 64 + lane) * pitch + pi * 8), (LAS unsigned*)((LAS char*)lds + AT_K + kt * 16640 + pi * 1040), 16, 0, 0);
            const int dblk = pi >> 2, rg = pi & 3;
            __builtin_amdgcn_global_load_lds((const unsigned*)(Vg + (size_t)(kt * 64 + 16 * rg + (lane >> 2)) * pitch + dblk * 32 + (lane & 3) * 8), (LAS unsigned*)((LAS char*)lds + AT_V8 + kt * 16384 + pi * 1024), 16, 0, 0); }
    }
    __syncthreads();
    for (int kt = 0; kt < nt; ++kt) {
        f32x16 p0, p1;
        {
            v4u ka; ka.x = hi ? 0x3F803F80u : 0u; ka.y = hi ? 0x3F80u : 0u; ka.z = 0u; ka.w = 0u;
            const bf16x8 qbv = __builtin_bit_cast(bf16x8, st.qb);
            at_qk<128, false>(p0, p1, (const LAS char*)lds + AT_K + kt * 16640, st.qr, r32, hi);
            p0 = __builtin_amdgcn_mfma_f32_32x32x16_bf16(__builtin_bit_cast(bf16x8, ka), qbv, p0, 0, 0, 0);
            p1 = __builtin_amdgcn_mfma_f32_32x32x16_bf16(__builtin_bit_cast(bf16x8, ka), qbv, p1, 0, 0, 0);
        }
        at_std_tile<128>(st, p0, p1, (const LAS char*)lds + AT_V8 + kt * 16384, 1 << 20, -(1 << 20), 0, true, wsf, lane, r32, hi);
    }
    __syncthreads();
}
template <int D, class RowPtr>
__device__ __forceinline__ void at_write(const f32x16 (&o)[D / 32], LAS unsigned char* lds, int wid, int lane, const RowPtr& rp) {
    lane = opq(lane); const int r32 = lane & 31, hi = lane >> 5;
    LAS bf16* stg = (LAS bf16*)(lds + AT_OST) + wid * (32 * D);
#pragma unroll
    for (int r = 0; r < 16; ++r) { const int orow = crow(r, hi);
#pragma unroll
        for (int d0 = 0; d0 < D / 32; ++d0) stg[orow * D + d0 * 32 + r32] = (bf16)f2bf(o[d0][r]); }
    LDS_WAIT();
    constexpr int CPR = D / 8;
    constexpr int RPI = 64 / CPR;
#pragma unroll
    for (int i = 0; i < 32 / RPI; ++i) { const int row = i * RPI + lane / CPR, ch = lane % CPR; const v4u v = *(const LAS v4u*)(stg + row * D + ch * 8); *(v4u*)(rp(row) + ch * 8) = v; }
    LDS_WAIT();
}

__device__ __forceinline__ void at_accum_lds(const f32x16 (&o)[2], const f32x16* ls, float f, bool first, LAS float* accb, LAS float* wsf, int r32, int hi) {
    if (hi == 0) wsf[r32] = f;
    LDS_WAIT();
#pragma unroll
    for (int g = 0; g < 4; ++g) { const f32x4 fv = *(const LAS f32x4*)(wsf + 8 * g + 4 * hi);
#pragma unroll
        for (int i = 0; i < 4; ++i) { const float fac = ls ? fv[i] * __builtin_amdgcn_rcpf((*ls)[4 * g + i]) : fv[i];
#pragma unroll
            for (int d = 0; d < 2; ++d) { LAS float* p = accb + (8 * g + 4 * hi + i) * 64 + d * 32 + r32; const float v = o[d][4 * g + i] * fac; *p = first ? v : (*p + v); } } }
    LDS_WAIT();
}
struct NsaRow { bf16* base; int pitch; __device__ bf16* operator()(int row) const { return base + (size_t)row * pitch; } };
__device__ __forceinline__ void nsa_unit(Frame& F, int b, int g, int tb, const bf16* HM, const bf16* CKV, const float* NG, bf16* YA) {
    LAS unsigned char* lds = F.lds; const int tid = (F.wave << 6) | lane_now(); const int wid = F.wave, lane = tid & 63, r32 = lane & 31, hi = lane >> 5;
    const int hd = wid >> 1, head = g * 4 + hd, tokl = (wid & 1) * 32 + r32, t = tb * 64 + tokl;
    LAS float* wsf = (LAS float*)(lds + AT_WS) + wid * 64;
    LAS float* imp = (LAS float*)(lds + AT_IMP);
    LAS unsigned* msk = (LAS unsigned*)(lds + AT_MASK);
    LAS int* tl = (LAS int*)(lds + AT_TL);
    AttnSt<64> st;
    { const bf16* qp = HM + ((size_t)(b * NHM + head) * SEQ + t) * 64;
#pragma unroll
      for (int d0 = 0; d0 < 4; ++d0) st.qr[d0] = *(const bf16x8*)(qp + d0 * 16 + hi * 8); }
    const float* ngp = NG + ((size_t)b * SEQ + t) * 24 + head * 3;
    const float g0 = ngp[0], g1 = ngp[1], g2 = ngp[2];
    LAS float* accb = (LAS float*)(lds + AT_OST) + wid * 2048;
    for (int i = tid; i < 64 * 65; i += 512) imp[i] = 0.f;
    if (tid < 130) msk[tid] = 0u;
    const bf16* Kc = CKV + (size_t)(b * 4 + 0 + g) * 256 * 64; const bf16* Vc = CKV + (size_t)(b * 4 + 2 + g) * 256 * 64;
    const int cmax = (t >= 31) ? ((t - 31) >> 4) : -1;
    const int ntc = (((tb * 64 + 63 - 31) >> 4) >> 6) + 1;
    float m = -1e30f, l = 0.f;
    __syncthreads();
    for (int kt = 0; kt < ntc; ++kt) { at_kdma64(Kc, 64, kt * 64, (LAS char*)lds + AT_K + kt * 8320, wid, lane); at_vdma64(Vc, 64, kt * 64, (LAS char*)lds + AT_V + kt * 8192, wid, lane); }
    __syncthreads();
    for (int kt = 0; kt < ntc; ++kt) {
        f32x16 p0, p1; at_qk<64>(p0, p1, (const LAS char*)lds + AT_K + kt * 8320, st.qr, r32, hi);
        const int lim = cmax - kt * 64;
#pragma unroll
        for (int r = 0; r < 16; ++r) { const int pl = crow(r, hi); p0[r] = (pl <= lim) ? p0[r] : -INFINITY; p1[r] = (pl + 32 <= lim) ? p1[r] : -INFINITY; }
        const float rm = pswap_max(max32(p0, p1));
        const float mn = fmaxf(m, rm);
        float sum = 0.f;
#pragma unroll
        for (int r = 0; r < 16; ++r) sum += __builtin_amdgcn_exp2f(p0[r] - mn) + __builtin_amdgcn_exp2f(p1[r] - mn);
        l = l * __builtin_amdgcn_exp2f(m - mn) + sum; m = mn;
    }
    l = pswap_sum(l);
    const float linv = (l > 0.f) ? 1.0f / l : 0.f;
    st.o[0] = f32x16{}; st.o[1] = f32x16{};
    for (int kt = 0; kt < ntc; ++kt) {
        f32x16 p0, p1; at_qk<64>(p0, p1, (const LAS char*)lds + AT_K + kt * 8320, st.qr, r32, hi);
        const int lim = cmax - kt * 64;
#pragma unroll
        for (int r = 0; r < 16; ++r) { const int pl = crow(r, hi);
            p0[r] = (pl <= lim) ? __builtin_amdgcn_exp2f(p0[r] - m) * linv : 0.f; p1[r] = (pl + 32 <= lim) ? __builtin_amdgcn_exp2f(p1[r] - m) * linv : 0.f; }
        LAS float* ir = imp + tokl * 65;
#pragma unroll
        for (int q = 0; q < 4; ++q) {
            { const int j = 16 * kt + 2 * q + hi; const float a = (p0[4 * q] + p0[4 * q + 1]) + (p0[4 * q + 2] + p0[4 * q + 3]);
              lds_fadd(ir + j, a); if (j + 1 < 64) lds_fadd(ir + j + 1, p0[4 * q + 3]); }
            { const int j = 16 * kt + 8 + 2 * q + hi; const float a = (p1[4 * q] + p1[4 * q + 1]) + (p1[4 * q + 2] + p1[4 * q + 3]);
              lds_fadd(ir + j, a); if (j + 1 < 64) lds_fadd(ir + j + 1, p1[4 * q + 3]); }
        }
        at_pv<64>(st.o, p0, p1, (const LAS char*)lds + AT_V + kt * 8192, lane, hi);
    }
    __syncthreads();
    {
        const int tid2 = (F.wave << 6) | lane_now();
        const int tk = tid2 >> 3, sub = tid2 & 7;
        LAS float* ir = imp + tk * 65;
        const int cur = tb;
        unsigned mybits_lo = 0u, mybits_hi = 0u;
        unsigned long long vals[8];
#pragma unroll
        for (int q = 0; q < 8; ++q) { const int j = sub * 8 + q; const float v = ir[j]; const float vq = (j == 0 || j == cur || j == cur - 1) ? 1e6f : v;
            vals[q] = (j > cur) ? 0ull : (((unsigned long long)__float_as_uint(vq) << 6) | (unsigned long long)(63 - j)); }
        int rank[8];
#pragma unroll
        for (int q = 0; q < 8; ++q) rank[q] = 0;
        for (int jj = 0; jj <= cur; ++jj) { const float v = ir[jj]; const float vv = (jj == 0 || jj == cur || jj == cur - 1) ? 1e6f : v;
            const unsigned long long kj = ((unsigned long long)__float_as_uint(vv) << 6) | (unsigned long long)(63 - jj);
#pragma unroll
            for (int q = 0; q < 8; ++q) rank[q] += (kj > vals[q]) ? 1 : 0; }
#pragma unroll
        for (int q = 0; q < 8; ++q) { const int j = sub * 8 + q; if (rank[q] < 16 && j <= cur) { if (j < 32) mybits_lo |= 1u << j; else mybits_hi |= 1u << (j - 32); } }
        if (mybits_lo) { lds_or(&msk[tk * 2], mybits_lo); lds_or(&msk[128], mybits_lo); }
        if (mybits_hi) { lds_or(&msk[tk * 2 + 1], mybits_hi); lds_or(&msk[129], mybits_hi); }
    }
    __syncthreads();
    at_accum_lds(st.o, nullptr, g0, true, accb, wsf, r32, hi);
    {
        if (tid < 64) { unsigned long long un = ((unsigned long long)msk[129] << 32) | msk[128]; un &= (tb >= 63) ? ~0ull : ((1ull << (tb + 1)) - 1ull);
            if ((un >> tid) & 1ull) tl[__popcll(un >> tid) - 1] = tid;
            if (tid == 0) tl[65] = __popcll(un); }
        __syncthreads();
        const int ntile = __builtin_amdgcn_readfirstlane(tl[65]);
        const int tokl2 = opq(tokl);
        const unsigned long long bits = ((unsigned long long)msk[tokl2 * 2 + 1] << 32) | msk[tokl2 * 2];
        const float sl2 = __builtin_amdgcn_exp2f(-(float)(head + 1)) * LOG2E;
        const bf16* Kg = HM + (size_t)(b * NHM + 8 + g) * SEQ * 64; const bf16* Vg = HM + (size_t)(b * NHM + 10 + g) * SEQ * 64;
        at_std_pass<64>(st, lds, Kg, Vg, 64, tl, ntile, t, bits, 1 << 30, sl2, wid, lane);
        at_accum_lds(st.o, &st.ls, g1, false, accb, wsf, r32, hi);
        __syncthreads();
        if (tid == 0) { int n = 0; for (int j = tb; j >= 0 && j >= tb - 8; --j) tl[n++] = j; tl[65] = n; }
        __syncthreads();
        const int ntw = __builtin_amdgcn_readfirstlane(tl[65]);
        const bf16* Kw = HM + (size_t)(b * NHM + 12 + g) * SEQ * 64; const bf16* Vw = HM + (size_t)(b * NHM + 14 + g) * SEQ * 64;
        at_std_pass<64>(st, lds, Kw, Vw, 64, tl, ntw, t, ~0ull, 512, sl2, wid, lane);
        at_accum_lds(st.o, &st.ls, g2, false, accb, wsf, r32, hi);
    }
    { bf16* yb = YA + ((size_t)b * SEQ + tb * 64 + (wid & 1) * 32) * 1536 + head * 64; const int lane3 = lane_now();
#pragma unroll
      for (int i = 0; i < 4; ++i) { const int row = i * 8 + (lane3 >> 3), ch = lane3 & 7; const f32x4 a = *(const LAS f32x4*)(accb + row * 64 + ch * 8), c = *(const LAS f32x4*)(accb + row * 64 + ch * 8 + 4);
          v4u w; w.x = cvt_pk_bf16(a[0], a[1]); w.y = cvt_pk_bf16(a[2], a[3]); w.z = cvt_pk_bf16(c[0], c[1]); w.w = cvt_pk_bf16(c[2], c[3]); *(v4u*)(yb + (size_t)row * 1536 + ch * 8) = w; }
      LDS_WAIT(); }
    __syncthreads();
}
__device__ __forceinline__ void moba_unit(Frame& F, int b, int h, int ib, const bf16* HM, const float* KMEAN, bf16* YB) {
    LAS unsigned char* lds = F.lds; const int tid = (F.wave << 6) | lane_now(); const int wid = F.wave, lane = tid & 63, r32 = lane & 31, hi = lane >> 5;
    LAS float* wsf = (LAS float*)(lds + AT_WS) + wid * 64;
    LAS unsigned* msk = (LAS unsigned*)(lds + AT_MASK);
    LAS int* tl = (LAS int*)(lds + AT_TL);
    LAS float* km = (LAS float*)(lds + AT_KM);
    const bf16* Qh = HM + (size_t)(b * NHM + 16 + h) * SEQ * 64;
    for (int i = tid; i < 16 * 64; i += 512) km[i] = KMEAN[(size_t)(b * 8 + h) * 1024 + i];
    if (tid == 0) msk[256] = 0u;
    __syncthreads();
    if (tid < 256) {
        const int tq = ib * 256 + tid; const bf16* qp = Qh + (size_t)tq * 64;
        float gate[16];
#pragma unroll
        for (int j = 0; j < 16; ++j) gate[j] = 0.f;
        for (int c = 0; c < 8; ++c) { const v4u qw = *(const v4u*)(qp + c * 8);
            float q[8]; q[0] = bflo(qw.x); q[1] = bfhi(qw.x); q[2] = bflo(qw.y); q[3] = bfhi(qw.y); q[4] = bflo(qw.z); q[5] = bfhi(qw.z); q[6] = bflo(qw.w); q[7] = bfhi(qw.w);
#pragma unroll
            for (int j = 0; j < 16; ++j) { if (j < ib) {
#pragma unroll
                for (int e = 0; e < 8; ++e) gate[j] += q[e] * km[j * 64 + c * 8 + e]; } } }
        unsigned sel = 0u; const int ntop = ib < 3 ? ib : 3;
        for (int k = 0; k < ntop; ++k) { float best = -INFINITY; int bj = 0;
#pragma unroll
            for (int j = 0; j < 16; ++j) { const bool ok = (j < ib) && !((sel >> j) & 1u); if (ok && gate[j] > best) { best = gate[j]; bj = j; } }
            sel |= 1u << bj; }
        msk[tid] = sel; if (sel) lds_or(&msk[256], sel);
    }
    __syncthreads();
    if (tid < 64) { const unsigned un = (msk[256] | (1u << ib)) & ((2u << ib) - 1u); const int kb = tid >> 2;
        if ((un >> kb) & 1u) tl[4 * (__popc(un >> kb) - 1) + (3 - (tid & 3))] = tid;
        if (tid == 0) tl[65] = 4 * __popc(un); }
    __syncthreads();
    const int ntile = __builtin_amdgcn_readfirstlane(tl[65]);
    const int t = ib * 256 + wid * 32 + r32;
    const unsigned selb = msk[wid * 32 + r32] | (1u << ib);
    unsigned xl = selb & 0xFFu, xh = (selb >> 8) & 0xFFu;
    xl = (xl | (xl << 12)) & 0x000F000Fu; xl = (xl | (xl << 6)) & 0x03030303u; xl = (xl | (xl << 3)) & 0x11111111u; xl *= 15u;
    xh = (xh | (xh << 12)) & 0x000F000Fu; xh = (xh | (xh << 6)) & 0x03030303u; xh = (xh | (xh << 3)) & 0x11111111u; xh *= 15u;
    const unsigned long long bits = ((unsigned long long)xh << 32) | xl;
    AttnSt<64> st;
    { const bf16* qp = Qh + (size_t)t * 64;
#pragma unroll
      for (int d0 = 0; d0 < 4; ++d0) st.qr[d0] = *(const bf16x8*)(qp + d0 * 16 + hi * 8); }
    const float sl2 = __builtin_amdgcn_exp2f(-(float)(h + 1)) * LOG2E;
    const bf16* Kg = HM + (size_t)(b * NHM + 24 + h) * SEQ * 64; const bf16* Vg = HM + (size_t)(b * NHM + 32 + h) * SEQ * 64;
    at_std_pass<64, true, true>(st, lds, Kg, Vg, 64, tl, ntile, t, bits, 1 << 30, sl2, wid, lane);
    at_normalize<2>(st.o, st.ls);
    NsaRow rp{YB + ((size_t)b * SEQ + ib * 256 + wid * 32) * 1536 + h * 64, 1536};
    at_write<64>(st.o, lds, wid, lane, rp);
    __syncthreads();
}
__device__ __forceinline__ void xattn_unit(Frame& F, int b, int h, int qb, const bf16* QX, const bf16* KVM, bf16* OX) {
    LAS unsigned char* lds = F.lds; const int tid = (F.wave << 6) | lane_now(); const int wid = F.wave, lane = tid & 63, r32 = lane & 31, hi = lane >> 5;
    LAS float* wsf = (LAS float*)(lds + AT_WS8) + wid * 64;
    const int tg = b * SEQ + qb * 256 + wid * 32 + r32;
    AttnSt<128> st;
    { const bf16* qp = QX + (size_t)tg * 512 + h * 128;
#pragma unroll
      for (int d0 = 0; d0 < 8; ++d0) st.qr[d0] = *(const bf16x8*)(qp + d0 * 16 + hi * 8); }
    const bf16* Kg = KVM + (size_t)b * MEM_LEN * 1024 + h * 128; const bf16* Vg = Kg + 512;
    at_pass_resident128(st, lds, Kg, Vg, 1024, MEM_LEN / 64, wid, lane);
    at_scale_rows<4>(st.o, st.ls, 1.0f / pswap_sum(st.l), wsf, r32, hi);
    NsaRow rp{OX + ((size_t)b * SEQ + qb * 256 + wid * 32) * 512 + h * 128, 512};
    at_write<128>(st.o, lds, wid, lane, rp);
    __syncthreads();
}

struct Args { const float* in[24]; float* out; unsigned char* ws; int ph_lo, ph_hi; };
constexpr int PH_PER_LAYER = 16, PH_TOTAL = 1 + DEPTH * PH_PER_LAYER;

__global__ void __launch_bounds__(NWAVES * 64, 2) mk_fwd(Args args) {
    extern __shared__ __attribute__((aligned(16))) unsigned char lds_raw[];
    LAS unsigned char* const ldsb = (LAS unsigned char*)lds_raw;
    const int wave0 = __builtin_amdgcn_readfirstlane((int)threadIdx.x >> 6);
    const int tid0 = (wave0 << 6) | lane_now();
    volatile LAS unsigned* MISC = (volatile LAS unsigned*)(ldsb + MISC_OFF);
    GAS unsigned char* ws = (GAS unsigned char*)args.ws;
    unsigned* ctl0 = (unsigned*)ws;
    for (int u = tid0; u < (LDS_BYTES - LDSCTL_OFF) / 4; u += NWAVES * 64) ((LAS unsigned*)(ldsb + LDSCTL_OFF))[u] = 0u;
    __syncthreads();
    XcdBarrier bar = xcd_barrier_post(ctl0 + CW_BAR, MISC + 8, tid0 == 0);
    const int lo = args.ph_lo, hi_ph = args.ph_hi;
    int phase = 0;
#ifndef PHMASK
#define PHMASK 0xFFFFFFFFu
#endif
#define PH_BEGIN(id) if (phase >= lo && phase < hi_ph) { if constexpr ((PHMASK >> (id)) & 1u) { Frame F; F.lds = ldsb; F.lane = lane_now(); F.wave = wave0; F.tid = (wave0 << 6) | F.lane; \
      int bx = blockIdx.x, gx = gridDim.x; asm volatile("" : "+s"(bx), "+s"(gx)); F.G = gx; F.vcu = (gx % 8 == 0) ? (bx % 8) * (gx / 8) + bx / 8 : bx; F.gw = F.vcu * NWAVES + F.wave; F.NGW = gx * NWAVES; \
      GAS unsigned char* wsq = ws; asm volatile("" : "+s"(wsq)); GAS unsigned char* const act = wsq + WS_ACT; (void)act; unsigned* const ctl = (unsigned*)wsq; (void)ctl; F.tsw = (unsigned long long*)(ctl + 40000); \
      for (int rep_ = 0; rep_ < ((((REPMASK) >> (id)) & 1u) ? 2 : 1); ++rep_) { if (rep_) __syncthreads();
#define PH_END   } } if (phase + 1 < hi_ph) xcd_barrier(bar, ((wave0 << 6) | lane_now()) == 0); } ++phase;
#define PH_END_G PH_END_GC(true)
#define PH_END_GC(cond_) } } if (phase + 1 < hi_ph) { int bq_ = blockIdx.x, gq_ = gridDim.x; asm volatile("" : "+s"(bq_), "+s"(gq_)); \
      if (gq_ == 256 && (cond_)) { GAS unsigned char* wq_ = ws; asm volatile("" : "+s"(wq_)); grp_barrier((unsigned*)wq_ + CW_BAR, (unsigned*)wq_ + CW_GRP + (bq_ & 7) * 32, 32u, ((wave0 << 6) | lane_now()) == 0); } \
      else xcd_barrier(bar, ((wave0 << 6) | lane_now()) == 0); } } ++phase;

#define GIN(i) ((const float*)(const GAS float*)args.in[i])
#define XIN    GIN(0)
#define MEMIN  GIN(1)
#define HB     ((bf16*)(GAS bf16*)(act + A_HB))
#define HM     ((bf16*)(GAS bf16*)(act + A_HM))
#define CMP    ((bf16*)(GAS bf16*)(act + A_CMP))
#define CONV   ((bf16*)(GAS bf16*)(act + A_CONV))
#define MG     ((bf16*)(GAS bf16*)(act + A_MG))
#define NG     ((float*)(GAS float*)(act + A_NG))
#define H1     ((bf16*)(GAS bf16*)(act + A_H1))
#define CKV    ((bf16*)(GAS bf16*)(act + A_CKV))
#define KMEAN  ((float*)(GAS float*)(act + A_KMEAN))
#define Y3     ((bf16*)(GAS bf16*)(act + A_Y3))
#define MERGED ((bf16*)(GAS bf16*)(act + A_MERGED))
#define DELTAB ((bf16*)(GAS bf16*)(act + A_DELTAB))
#define QX     ((bf16*)(GAS bf16*)(act + A_QX))
#define MEMB   ((bf16*)(GAS bf16*)(act + A_MEMB))
#define KVMall ((bf16*)(GAS bf16*)(act + A_KVM))
#define OX     ((bf16*)(GAS bf16*)(act + A_OX))
#define RS     ((float*)(GAS float*)(act + A_RS))
#define HS     ((bf16*)(GAS bf16*)(act + A_HS))
#define RIDX   ((int*)(GAS int*)(act + A_RIDX))
#define RW     ((float*)(GAS float*)(act + A_RW))
#define RRANK  ((int*)(GAS int*)(act + A_RRANK))
#define RPOS   ((int*)(GAS int*)(act + A_RPOS))
#define ROWTOK ((int*)(GAS int*)(act + A_ROWW))
#define BLKE   ((int*)(GAS int*)(act + A_BLKE))
#define XG     ((bf16*)(GAS bf16*)(act + A_XG))
#define HE     ((bf16*)(GAS bf16*)(act + A_HE))
#define YE     XG
#define KVM    (KVMall + (size_t)l * TM * DM)
#define wl     ((unsigned char*)(wsq + WS_W + (size_t)l * WL_BYTES))
#define wlx(L_) ((unsigned char*)(wsq + WS_W + (size_t)(L_) * WL_BYTES))

    PH_BEGIN(0)
        {
          int off = 0;
#define GWR(n_) ({ int g_ = F.gw - off % F.NGW; if (g_ < 0) g_ += F.NGW; off += (n_); g_; })
          const int l2 = 0;
            cvt_fast(F, GIN(2) + (size_t)l2 * DM * N_IN, N_IN, DM, N_INP, (bf16*)(wlx(l2) + WL_WIN), DM, Map64Win{}, 1, 0, 0, GWR(1920), F.NGW);
            cvt_fast(F, GIN(4) + (size_t)l2 * 2 * 2048 * 256, 256, 2048, 256, (bf16*)(wlx(l2) + WL_W1C), 2048, Map64Ident{}, 2, (size_t)2048 * 256, (size_t)256 * 2048, GWR(256), F.NGW);
            cvt_fast(F, GIN(5) + (size_t)l2 * 2 * 256 * 64, 64, 256, 256, (bf16*)(wlx(l2) + WL_W2C), 256, Map64Pad{64}, 2, (size_t)256 * 64, (size_t)256 * 256, GWR(32), F.NGW);
            cvt_fast(F, GIN(7) + (size_t)l2 * 3 * 512 * 1024, 1024, 512, 1024, (bf16*)(wlx(l2) + WL_WB), 1536, Map64Ident{}, 3, (size_t)512 * 1024, (size_t)512, GWR(384), F.NGW);
            cvt_fast(F, GIN(8) + (size_t)l2 * 1024 * 1024, 1024, 1024, 1024, (bf16*)(wlx(l2) + WL_WOUT), 1024, Map64Ident{}, 1, 0, 0, GWR(256), F.NGW);
            cvt_fast(F, GIN(11) + (size_t)l2 * 1024 * 512, 512, 1024, 512, (bf16*)(wlx(l2) + WL_WQ), 1024, Map64Ident{}, 1, 0, 0, GWR(128), F.NGW);
            cvt_fast(F, GIN(12) + (size_t)l2 * 1024 * 1024, 1024, 1024, 1024, (bf16*)(wlx(l2) + WL_WKV), 1024, Map64Ident{}, 1, 0, 0, GWR(256), F.NGW);
            cvt_fast(F, GIN(13) + (size_t)l2 * 512 * 1024, 1024, 512, 1024, (bf16*)(wlx(l2) + WL_WO), 512, Map64Ident{}, 1, 0, 0, GWR(128), F.NGW);
            cvt_fast(F, GIN(16) + (size_t)l2 * 1024 * 256, 256, 1024, 256, (bf16*)(wlx(l2) + WL_WRS), 1024, Map64Ident{}, 1, 0, 0, GWR(64), F.NGW);
            cvt_fast(F, GIN(20) + (size_t)l2 * 1024 * 512, 512, 1024, 512, (bf16*)(wlx(l2) + WL_WRS) + (size_t)256 * 1024, 1024, Map64AG{256}, 1, 0, 0, GWR(128), F.NGW);
            cvt_fast(F, GIN(21) + (size_t)l2 * 256 * 1024, 1024, 256, 1024, (bf16*)(wlx(l2) + WL_WS2), 256, Map64Ident{}, 1, 0, 0, GWR(64), F.NGW);
#undef GWR
        }
        for (int o = F.gw; o < DEPTH * 2 * 256; o += F.NGW) { const int li = o >> 8, n = o & 255; const float* pe = GIN(3) + (size_t)li * 2048; const float* w1 = GIN(4) + (size_t)li * 2048 * 256;
            float sacc = 0.f; for (int k = F.lane; k < 2048; k += 64) sacc += pe[k] * w1[(size_t)k * 256 + n];
            sacc = wave_sum(sacc, F.lane);
            if (F.lane == 0) ((float*)(wsq + WS_W + (size_t)(li >> 1) * WL_BYTES + WL_CB))[(li & 1) * 256 + n] = sacc; }
        { const size_t n4 = (size_t)T * DM / 4, st = (size_t)F.NGW * 64;
          for (size_t i = (size_t)F.gw * 64 + F.lane; i < n4; i += 4 * st) { f32x4 v[4];
#pragma unroll
              for (int q = 0; q < 4; ++q) if (i + q * st < n4) v[q] = ((const f32x4*)XIN)[i + q * st];
#pragma unroll
              for (int q = 0; q < 4; ++q) if (i + q * st < n4) { v2u w; w.x = cvt_pk_bf16(v[q][0], v[q][1]); w.y = cvt_pk_bf16(v[q][2], v[q][3]); ((v2u*)HB)[i + q * st] = w; } } }
        for (size_t i = (size_t)F.gw * 64 + F.lane; i < (size_t)TM * DM / 4; i += (size_t)F.NGW * 64) { const f32x4 v = ((const f32x4*)MEMIN)[i]; v2u w; w.x = cvt_pk_bf16(v[0], v[1]); w.y = cvt_pk_bf16(v[2], v[3]); ((v2u*)MEMB)[i] = w; }
        if (bx == 1) for (int i = F.tid; i < DM / 2; i += 512) ((unsigned*)(HB + (size_t)T * DM))[i] = 0u;
        if (bx == 0) for (int i = F.tid; i < 2048; i += 512) ((unsigned*)(CMP + (size_t)BATCH * 4 * SEQ * 64))[i] = 0u;
    PH_END

    for (int l = 0; l < DEPTH; ++l) {
        PH_BEGIN(1)
            pg8::Gemm g{HB, (const bf16*)(wl + WL_WIN), DM, DM}; pg8::StaticOrder S; S.init(T, N_INP, F.G, bx);
            EpiWin E{HM, CMP, CONV, MG, NG};
            const int nround = (S.nwg + F.G - 1) / F.G, ksplit = (F.G == 256) ? ((F.vcu >> 5) * nround) / 8 : (int)(((long)F.vcu * nround) / F.G);
            S.i0 = 0; S.imax = ksplit;
            pg8::gemm_phase<EpiWin, pg8::StaticOrder>(F.lds, g, S, E, wave0);
            __syncthreads();
            cvt_fast(F, GIN(18) + (size_t)l * NEXP * 1024 * 512, 512, 1024, 512, (bf16*)(wl + WL_W13), 1024, Map64AG{256}, NEXP, (size_t)1024 * 512, (size_t)512 * 1024, F.gw, F.NGW);
            cvt_fast(F, GIN(19) + (size_t)l * NEXP * 256 * 1024, 1024, 256, 1024, (bf16*)(wl + WL_W2), 256, Map64Ident{}, NEXP, (size_t)256 * 1024, (size_t)1024 * 256, F.gw, F.NGW);
            if (l == 0) {
                int off = 0;
#define GWR(n_) ({ int g_ = F.gw - off % F.NGW; if (g_ < 0) g_ += F.NGW; off += (n_); g_; })
                for (int l2 = 1; l2 < DEPTH; ++l2) {
                cvt_fast(F, GIN(4) + (size_t)l2 * 2 * 2048 * 256, 256, 2048, 256, (bf16*)(wlx(l2) + WL_W1C), 2048, Map64Ident{}, 2, (size_t)2048 * 256, (size_t)256 * 2048, GWR(256), F.NGW);
                cvt_fast(F, GIN(5) + (size_t)l2 * 2 * 256 * 64, 64, 256, 256, (bf16*)(wlx(l2) + WL_W2C), 256, Map64Pad{64}, 2, (size_t)256 * 64, (size_t)256 * 256, GWR(32), F.NGW);
                cvt_fast(F, GIN(7) + (size_t)l2 * 3 * 512 * 1024, 1024, 512, 1024, (bf16*)(wlx(l2) + WL_WB), 1536, Map64Ident{}, 3, (size_t)512 * 1024, (size_t)512, GWR(384), F.NGW);
                cvt_fast(F, GIN(8) + (size_t)l2 * 1024 * 1024, 1024, 1024, 1024, (bf16*)(wlx(l2) + WL_WOUT), 1024, Map64Ident{}, 1, 0, 0, GWR(256), F.NGW);
                cvt_fast(F, GIN(11) + (size_t)l2 * 1024 * 512, 512, 1024, 512, (bf16*)(wlx(l2) + WL_WQ), 1024, Map64Ident{}, 1, 0, 0, GWR(128), F.NGW);
                cvt_fast(F, GIN(12) + (size_t)l2 * 1024 * 1024, 1024, 1024, 1024, (bf16*)(wlx(l2) + WL_WKV), 1024, Map64Ident{}, 1, 0, 0, GWR(256), F.NGW);
                cvt_fast(F, GIN(13) + (size_t)l2 * 512 * 1024, 1024, 512, 1024, (bf16*)(wlx(l2) + WL_WO), 512, Map64Ident{}, 1, 0, 0, GWR(128), F.NGW);
                cvt_fast(F, GIN(16) + (size_t)l2 * 1024 * 256, 256, 1024, 256, (bf16*)(wlx(l2) + WL_WRS), 1024, Map64Ident{}, 1, 0, 0, GWR(64), F.NGW);
                cvt_fast(F, GIN(20) + (size_t)l2 * 1024 * 512, 512, 1024, 512, (bf16*)(wlx(l2) + WL_WRS) + (size_t)256 * 1024, 1024, Map64AG{256}, 1, 0, 0, GWR(128), F.NGW);
                cvt_fast(F, GIN(21) + (size_t)l2 * 256 * 1024, 1024, 256, 1024, (bf16*)(wlx(l2) + WL_WS2), 256, Map64Ident{}, 1, 0, 0, GWR(64), F.NGW);
                }
                cvt_fast(F, GIN(2) + (size_t)1 * DM * N_IN, N_IN, DM, N_INP, (bf16*)(wlx(1) + WL_WIN), DM, Map64Win{}, 1, 0, 0, GWR(1920), F.NGW);
            }
#undef GWR
            __syncthreads();
            S.i0 = ksplit; S.imax = 1 << 30;
            pg8::gemm_phase<EpiWin, pg8::StaticOrder>(F.lds, g, S, E, wave0);
        PH_END_G
        PH_BEGIN(2)
            const bool grp = (F.G == 256); const int gj = F.vcu & 31, gg = F.vcu >> 5;
            const int cmpG = grp ? (1 << 20) : F.G, cmpC = grp ? ((gj < 4) ? 4 * gg + gj : (1 << 20)) : bx;
            { pg8::Gemm g{CMP, (const bf16*)(wl + WL_W1C), 1024, 2048}; SchedCmp S{cmpG, cmpC}; EpiCmp1 E{H1, (const float*)(wl + WL_CB)};
              pg8::gemm_phase<EpiCmp1, SchedCmp>(F.lds, g, S, E, wave0); }
            { pg8::Gemm g{MEMB, (const bf16*)(wl + WL_WKV), DM, DM}; EpiBf16 E{KVM, 1024, 1.0f};
              if (grp) { SchedOpt S{gg, gj - 4, gj >= 4 && gj < 8}; pg8::gemm_phase<EpiBf16, SchedOpt>(F.lds, g, S, E, wave0); }
              else { pg8::StaticOrder S; S.init(TM, 1024, F.G, ((bx + F.G - 32) % F.G)); pg8::gemm_phase<EpiBf16, pg8::StaticOrder>(F.lds, g, S, E, wave0); } }
            asm volatile("s_waitcnt vmcnt(0)" ::: "memory"); __builtin_amdgcn_fence(__ATOMIC_ACQUIRE, "agent"); asm volatile("s_waitcnt vmcnt(0)" ::: "memory"); __syncthreads();
            { pg8::Gemm g{H1, (const bf16*)(wl + WL_W2C), 256, 256}; SchedCmp S{cmpG, cmpC}; EpiCmp2 E{CKV};
              pg8::gemm_phase<EpiCmp2, SchedCmp>(F.lds, g, S, E, wave0); }
            for (int o = grp ? ((gj >= 8 && gj < 24) ? gg * 128 + (gj - 8) * NWAVES + F.wave : BATCH * 8 * 16) : F.gw; o < BATCH * 8 * 16; o += grp ? BATCH * 8 * 16 : F.NGW) { const int b = o >> 7, h = (o >> 4) & 7, blk = o & 15; const bf16* kp = HM + ((size_t)(b * NHM + 24 + h) * SEQ + blk * 256) * 64 + (F.lane >> 3) * 64 + (F.lane & 7) * 8;
                float a8[8];
#pragma unroll
                for (int e = 0; e < 8; ++e) a8[e] = 0.f;
#pragma unroll 8
                for (int i = 0; i < 32; ++i) { const v4u w = *(const v4u*)(kp + (size_t)i * 8 * 64);
                    a8[0] += bflo(w.x); a8[1] += bfhi(w.x); a8[2] += bflo(w.y); a8[3] += bfhi(w.y); a8[4] += bflo(w.z); a8[5] += bfhi(w.z); a8[6] += bflo(w.w); a8[7] += bfhi(w.w); }
#pragma unroll
                for (int e = 0; e < 8; ++e) { float v = a8[e]; v += shx(v, 8, F.lane); v += shx(v, 16, F.lane); v += shx(v, 32, F.lane); a8[e] = v * (1.0f / 256.0f); }
                if (F.lane < 8) { float* dp = KMEAN + (size_t)o * 64 + F.lane * 8; *(f32x4*)dp = (f32x4){a8[0], a8[1], a8[2], a8[3]}; *(f32x4*)(dp + 4) = (f32x4){a8[4], a8[5], a8[6], a8[7]}; } }
            { const float* cw = GIN(6) + (size_t)l * 3 * 512; bf16* YC = Y3 + 1024; const bf16* cv_ = CONV; const int st = NWAVES * 64;
              int o_lo, o_hi;
              if (grp) { constexpr int QN = 1214; const int q0 = (gj < 4) ? gj : (gj < 8) ? 4 + 5 * (gj - 4) : 24 + 8 * (gj - 8), nq = (gj < 4) ? 1 : (gj < 8) ? 5 : 8;
                  const int base = gg * SEQ * 64; o_lo = base + q0 * QN; o_hi = base + (q0 + nq) * QN; if (o_hi > base + SEQ * 64) o_hi = base + SEQ * 64; }
              else { const int per = (T * 64 + F.G - 1) / F.G; o_lo = F.vcu * per; o_hi = o_lo + per; if (o_hi > T * 64) o_hi = T * 64; }
              for (int o = o_lo + F.wave * 64 + F.lane; o < o_hi; o += 2 * st) {
                  v4u hv[2][3], cv[2][3], bv[2]; int tt[2], cc[2]; bool ok[2];
#pragma unroll
                  for (int q = 0; q < 2; ++q) { const int oq = o + q * st; ok[q] = oq < o_hi; const int t = ok[q] ? (oq >> 6) : 0, c0 = (oq & 63) * 8; tt[q] = t; cc[q] = c0; const int sq = t & (SEQ - 1); const int e0 = t * 1536 + c0;
#pragma unroll
                      for (int k = 0; k < 3; ++k) { const int ss = sq - 2 + k; const int er = (ss >= 0) ? e0 + (k - 2) * 1536 : e0; hv[q][k] = *(const v4u*)(cv_ + er); cv[q][k] = *(const v4u*)(cv_ + er + 1024);
                          if (ss < 0) { hv[q][k] = (v4u){0u, 0u, 0u, 0u}; } }
                      bv[q] = *(const v4u*)(cv_ + e0 + 512); }
#pragma unroll
                  for (int q = 0; q < 2; ++q) { if (!ok[q]) continue; float acc[8];
#pragma unroll
                      for (int e = 0; e < 8; ++e) acc[e] = 0.f;
#pragma unroll
                      for (int k = 0; k < 3; ++k) { const float* wk = cw + k * 512 + cc[q]; const v4u h = hv[q][k], c = cv[q][k];
                          acc[0] += wk[0] * bflo(h.x) * bflo(c.x); acc[1] += wk[1] * bfhi(h.x) * bfhi(c.x); acc[2] += wk[2] * bflo(h.y) * bflo(c.y); acc[3] += wk[3] * bfhi(h.y) * bfhi(c.y);
                          acc[4] += wk[4] * bflo(h.z) * bflo(c.z); acc[5] += wk[5] * bfhi(h.z) * bfhi(c.z); acc[6] += wk[6] * bflo(h.w) * bflo(c.w); acc[7] += wk[7] * bfhi(h.w) * bfhi(c.w); }
                      const v4u b = bv[q];
                      v4u w; w.x = cvt_pk_bf16(acc[0] * bflo(b.x), acc[1] * bfhi(b.x)); w.y = cvt_pk_bf16(acc[2] * bflo(b.y), acc[3] * bfhi(b.y)); w.z = cvt_pk_bf16(acc[4] * bflo(b.z), acc[5] * bfhi(b.z)); w.w = cvt_pk_bf16(acc[6] * bflo(b.w), acc[7] * bfhi(b.w));
                      *(v4u*)(YC + (size_t)tt[q] * 1536 + cc[q]) = w; } } }
        PH_END_G
        PH_BEGIN(18)
            { bf16* YB = Y3 + 512;
              if (F.G == 256) { const int bh = F.vcu >> 2, s4 = F.vcu & 3;
                  for (int i = 0; i < 4; ++i) { const int ib = (i == 0) ? s4 : (i == 1) ? 7 - s4 : (i == 2) ? 8 + s4 : 15 - s4; moba_unit(F, bh >> 3, bh & 7, ib, HM, KMEAN, YB); } }
              else for (int u = F.vcu; u < 1024; u += F.G) moba_unit(F, u >> 7, (u >> 4) & 7, u & 15, HM, KMEAN, YB); }
            __syncthreads();
            { bf16* YA = Y3;
              if (F.G == 256) { const int bg = F.vcu >> 4, s16 = F.vcu & 15;
                  for (int i = 0; i < 4; ++i) { const int tb = (i == 0) ? s16 : (i == 1) ? 31 - s16 : (i == 2) ? 32 + s16 : 63 - s16; nsa_unit(F, bg >> 1, bg & 1, tb, HM, CKV, NG, YA); } }
              else for (int u = F.vcu; u < 1024; u += F.G) nsa_unit(F, u >> 7, (u >> 6) & 1, u & 63, HM, CKV, NG, YA); }
        PH_END_G
        PH_BEGIN(5)
            pg8::Gemm g{Y3, (const bf16*)(wl + WL_WB), 1536, 1536}; pg8::StaticOrder S; S.init(T, DM, F.G, bx); EpiMergeK E{MG, MERGED};
            pg8::gemm_phase<EpiMergeK, pg8::StaticOrder>(F.lds, g, S, E, wave0);
        PH_END_G
        PH_BEGIN(6)
            pg8::Gemm g{MERGED, (const bf16*)(wl + WL_WOUT), DM, DM}; pg8::StaticOrder S; S.init(T, DM, F.G, bx); EpiBf16 E{DELTAB, DM, 1.0f};
            pg8::gemm_phase<EpiBf16, pg8::StaticOrder>(F.lds, g, S, E, wave0);
        PH_END_G
        PH_BEGIN(7)
            ln_phase<false>(F, HB, DELTAB, nullptr, nullptr, nullptr, GIN(9) + (size_t)l * DM, GIN(10) + (size_t)l * DM, nullptr, HB);
        PH_END_G
        PH_BEGIN(8)
            pg8::Gemm g{HB, (const bf16*)(wl + WL_WQ), DM, DM}; pg8::StaticOrder S; S.init(T, 512, F.G, bx); EpiBf16 E{QX, 512, QSC128};
            pg8::gemm_phase<EpiBf16, pg8::StaticOrder>(F.lds, g, S, E, wave0);
        PH_END_G
        PH_BEGIN(9)
            if (F.G == 256) { for (int k = 0; k < 2; ++k) { const int uu = (F.vcu & 31) + 32 * k; xattn_unit(F, F.vcu >> 5, uu >> 4, uu & 15, QX, KVM, OX); } }
            else for (int u = F.vcu; u < BATCH * 4 * 16; u += F.G) xattn_unit(F, u >> 6, (u >> 4) & 3, u & 15, QX, KVM, OX);
        PH_END_G
        PH_BEGIN(10)
            pg8::Gemm g{OX, (const bf16*)(wl + WL_WO), 512, 512}; pg8::StaticOrder S; S.init(T, DM, F.G, bx); EpiBf16 E{DELTAB, DM, 1.0f};
            pg8::gemm_phase<EpiBf16, pg8::StaticOrder>(F.lds, g, S, E, wave0);
        PH_END_G
        PH_BEGIN(11)
            ln_phase<false>(F, HB, DELTAB, nullptr, nullptr, nullptr, GIN(14) + (size_t)l * DM, GIN(15) + (size_t)l * DM, nullptr, HB);
        PH_END_G
        PH_BEGIN(12)
            pg8::Gemm g{HB, (const bf16*)(wl + WL_WRS), DM, DM}; pg8::StaticOrder S; S.init(T, 768, F.G, bx); EpiRS E{RS, HS};
            pg8::gemm_phase<EpiRS, pg8::StaticOrder>(F.lds, g, S, E, wave0);
        PH_END_G
        PH_BEGIN(13)
            { pg8::Gemm g{HS, (const bf16*)(wl + WL_WS2), 256, 256}; pg8::StaticOrder S; S.init(T, DM, F.G, bx); EpiBf16 E{DELTAB, DM, 1.0f};
              pg8::gemm_phase<EpiBf16, pg8::StaticOrder>(F.lds, g, S, E, wave0); }
            const float* rb = GIN(17) + (size_t)l * NEXP; unsigned* cnt = ctl + CW_CNT + l * NEXP;
            const int lane = F.lane;
            const f32x4 rbv = *(const f32x4*)(rb + lane * 4);
            const bool grp = (F.G == 256);
            for (int t = grp ? (F.vcu >> 5) * SEQ + (F.vcu & 31) * NWAVES + F.wave : F.gw; t < (grp ? ((F.vcu >> 5) + 1) * SEQ : T); t += grp ? 32 * NWAVES : F.NGW) {
                const f32x4 lg = *(const f32x4*)(RS + (size_t)t * 256 + lane * 4);
                float s[4], sb[4];
#pragma unroll
                for (int j = 0; j < 4; ++j) { s[j] = sigmoidf_(lg[j]); sb[j] = s[j] + rbv[j]; }
                float m1 = fmaxf(sb[0], sb[1]), m2 = fminf(sb[0], sb[1]);
                { const float a = fmaxf(sb[2], sb[3]), c = fminf(sb[2], sb[3]); const float n1 = fmaxf(m1, a), n2 = fmaxf(fminf(m1, a), fmaxf(m2, c)); m1 = n1; m2 = n2; }
#pragma unroll
                for (int o = 1; o < 8; o <<= 1) { const float a1 = shx(m1, o, lane), a2 = shx(m2, o, lane); const float n1 = fmaxf(m1, a1), n2 = fmaxf(fminf(m1, a1), fmaxf(m2, a2)); m1 = n1; m2 = n2; }
                const float gs = m1 + m2; const int mygrp = lane >> 3;
                int grank = 0;
#pragma unroll
                for (int gq = 0; gq < 8; ++gq) { const float og = shf(gs, gq * 8); grank += (og > gs || (og == gs && gq < mygrp)) ? 1 : 0; }
                const bool gsel = grank < 4;
                float cand[4];
#pragma unroll
                for (int j = 0; j < 4; ++j) cand[j] = gsel ? sb[j] : -1e30f;
                unsigned key[4];
#pragma unroll
                for (int j = 0; j < 4; ++j) { const unsigned u = __float_as_uint(cand[j]); key[j] = gsel ? ((u & 0x80000000u) ? ~u : (u | 0x80000000u)) : 0u; }
                unsigned Tk = 0u;
                for (int bit = 31; bit >= 0; --bit) { const unsigned trial = Tk | (1u << bit);
                    const int cnt = __popcll(__ballot(key[0] >= trial)) + __popcll(__ballot(key[1] >= trial)) + __popcll(__ballot(key[2] >= trial)) + __popcll(__ballot(key[3] >= trial));
                    if (cnt >= TOPK) Tk = trial; }
                int ngt = 0, tie_lo = 0, mytie[4], mysel[4];
#pragma unroll
                for (int j = 0; j < 4; ++j) { const unsigned long long bg = __ballot(key[j] > Tk), be = __ballot(key[j] == Tk); ngt += __popcll(bg);
                    tie_lo += __builtin_amdgcn_mbcnt_hi((unsigned)(be >> 32), __builtin_amdgcn_mbcnt_lo((unsigned)be, 0)); mytie[j] = (key[j] == Tk) ? 1 : 0; }
                const int need = TOPK - ngt;
                { int t_before = tie_lo;
#pragma unroll
                  for (int j = 0; j < 4; ++j) { mysel[j] = (key[j] > Tk) ? 1 : ((mytie[j] && t_before < need) ? 1 : 0); t_before += mytie[j]; } }
                int slot = 0;
#pragma unroll
                for (int j = 0; j < 4; ++j) { const unsigned long long bs = __ballot(mysel[j] != 0); slot += __builtin_amdgcn_mbcnt_hi((unsigned)(bs >> 32), __builtin_amdgcn_mbcnt_lo((unsigned)bs, 0)); }
                LAS float* cv = (LAS float*)F.lds + F.wave * 512;
#pragma unroll
                for (int j = 0; j < 4; ++j) { if (mysel[j]) { ((LAS int*)cv)[256 + slot] = lane * 4 + j; cv[264 + slot] = s[j]; } slot += mysel[j]; }
                LDS_WAIT();
                int myidx = 0; float myw = 0.f;
                if (lane < TOPK) { myidx = ((LAS int*)cv)[256 + lane]; myw = cv[264 + lane]; }
                LDS_WAIT();
                float wsum = (lane < TOPK) ? myw : 0.f;
#pragma unroll
                for (int o = 1; o < 8; o <<= 1) wsum += shx(wsum, o, lane);
                if (lane < TOPK) { const float w = myw / wsum * 2.5f; const unsigned rk = atomicAdd(&cnt[myidx], 1u);
                    RIDX[(size_t)t * 8 + lane] = myidx; RW[(size_t)t * 8 + lane] = w; RRANK[(size_t)t * 8 + lane] = (int)rk; }
            }
        PH_END
        PH_BEGIN(14)
            LAS int* pst = (LAS int*)F.lds; unsigned* cnt = ctl + CW_CNT + l * NEXP;
            if (F.tid < NEXP) pst[256 + F.tid] = (int)((__hip_atomic_load(&cnt[F.tid], __ATOMIC_RELAXED, __HIP_MEMORY_SCOPE_AGENT) + 255u) >> 8);
            __syncthreads();
            { const int nbv = (F.tid < NEXP) ? pst[256 + F.tid] : 0; int inc = nbv;
#pragma unroll
              for (int o = 1; o < 64; o <<= 1) { const int up = __builtin_amdgcn_ds_bpermute(((F.lane - o) & 63) << 2, inc); if (F.lane >= o) inc += up; }
              if (F.tid < NEXP && F.lane == 63) pst[520 + F.wave] = inc;
              __syncthreads();
              if (F.tid < NEXP) { int base = 0; for (int w = 0; w < F.wave; ++w) base += pst[520 + w]; pst[F.tid] = base + inc - nbv; if (F.tid == NEXP - 1) pst[512] = base + inc; } }
            __syncthreads();
            if (bx == 0) { for (int e = F.tid; e < NEXP; e += 512) { const int b0 = pst[e], nb = pst[256 + e]; const int c = (int)__hip_atomic_load(&cnt[e], __ATOMIC_RELAXED, __HIP_MEMORY_SCOPE_AGENT);
                for (int q = 0; q < nb; ++q) { const int nr = (c - q * 256 < 256) ? c - q * 256 : 256; BLKE[b0 + q] = e | (nr << 16); } }
                if (F.tid == 0) BLKE[NBLK_MAX] = pst[512]; }
            for (int a = F.gw * 64 + F.lane; a < T * TOPK; a += F.NGW * 64) { const int e = RIDX[a], rk = RRANK[a]; const int dest = pst[e] * 256 + rk; ROWTOK[dest] = a >> 3; RPOS[a] = dest; }
            for (int e = F.vcu; e < NEXP; e += F.G) { const int c = (int)__hip_atomic_load(&cnt[e], __ATOMIC_RELAXED, __HIP_MEMORY_SCOPE_AGENT); const int r0 = pst[e] * 256 + c, r1 = (pst[e] + pst[256 + e]) * 256;
                for (int r = r0 + F.tid; r < r1; r += NWAVES * 64) ROWTOK[r] = T; }
            __syncthreads();
        PH_END
        PH_BEGIN(15)
            LAS int* bt = (LAS int*)(F.lds + LDSCTL_OFF + 1024);
            for (int i = F.tid; i <= NBLK_MAX; i += NWAVES * 64) bt[i] = BLKE[i];
            __syncthreads();
            const int NBq = __builtin_amdgcn_readfirstlane(bt[NBLK_MAX]);
            pg8::Gemm g{HB, (const bf16*)(wl + WL_W13), DM, DM, ROWTOK}; SchedGrouped S{F.G, F.vcu, 2, NBq, bt}; EpiE1 E{HE};
            pg8::gemm_phase<EpiE1, SchedGrouped, true, true, true>(F.lds, g, S, E, wave0);
        PH_END
        PH_BEGIN(16)
            LAS int* bt = (LAS int*)(F.lds + LDSCTL_OFF + 1024);
            for (int i = F.tid; i <= NBLK_MAX; i += NWAVES * 64) bt[i] = BLKE[i];
            __syncthreads();
            const int NBq = __builtin_amdgcn_readfirstlane(bt[NBLK_MAX]);
            { pg8::Gemm g{HE, (const bf16*)(wl + WL_W2), 256, 256}; SchedGrouped S{F.G, F.vcu, 4, NBq, bt}; EpiE2 E{YE};
              pg8::gemm_phase<EpiE2, SchedGrouped>(F.lds, g, S, E, wave0); }
        PH_END

        PH_BEGIN(17)
            float* outf = (l == DEPTH - 1) ? (float*)(GAS float*)args.out : nullptr;
            const float dsc = 1.0f;
            ln_phase<true>(F, HB, DELTAB, YE, RPOS, RW, GIN(22) + (size_t)l * DM, GIN(23) + (size_t)l * DM, outf, (l == DEPTH - 1) ? nullptr : HB, dsc);
        PH_END_G
    }
#undef PH_BEGIN
#undef PH_END
#undef PH_END_G
#undef PH_END_GC
}

extern "C" void kernel_launch(void* const* d_in, const int* in_sizes, int n_in, void* d_out, int out_size, void* d_ws, size_t ws_size, hipStream_t stream) {
    static int grid = 0;
    if (grid == 0) {
        if (n_in != 24 || ws_size < WS_END) { fprintf(stderr, "kernel_launch: need 24 inputs and %zu bytes of workspace (got %d, %zu)\n", (size_t)WS_END, n_in, ws_size); grid = -1; return; }
        int dev = 0, cus = 0, per_cu = 0;
        if (hipGetDevice(&dev) != hipSuccess || hipDeviceGetAttribute(&cus, hipDeviceAttributeMultiprocessorCount, dev) != hipSuccess) { grid = -1; return; }
        if (hipFuncSetAttribute((const void*)mk_fwd, hipFuncAttributeMaxDynamicSharedMemorySize, LDS_BYTES) != hipSuccess) { fprintf(stderr, "kernel_launch: hipFuncSetAttribute failed\n"); grid = -1; return; }
        if (hipOccupancyMaxActiveBlocksPerMultiprocessor(&per_cu, (const void*)mk_fwd, NWAVES * 64, LDS_BYTES) != hipSuccess || per_cu < 1) { fprintf(stderr, "kernel_launch: occupancy query says %d\n", per_cu); }
        (void)hipGetLastError();
        grid = cus;
    }
    if (grid < 0) return;
    (void)hipMemsetAsync(d_ws, 0, CTL_BYTES, stream);
    Args a{};
    for (int i = 0; i < 24; ++i) a.in[i] = (const float*)d_in[i];
    a.out = (float*)d_out; a.ws = (unsigned char*)d_ws;
#ifndef MK_CUTS
    a.ph_lo = 0; a.ph_hi = PH_TOTAL;
    hipLaunchKernelGGL(mk_fwd, dim3(grid), dim3(NWAVES * 64), LDS_BYTES, stream, a);
#else
    for (int p = 0; p < PH_TOTAL; ++p) { a.ph_lo = p; a.ph_hi = p + 1; hipLaunchKernelGGL(mk_fwd, dim3(grid), dim3(NWAVES * 64), LDS_BYTES, stream, a); }
#endif
}
```

```cpp
#include <hip/hip_runtime.h>
#include <cstdio>
#include <cstdint>

#ifndef REPMASK
#define REPMASK 0x0u
#endif
constexpr int DM = 1024, BATCH = 8, SEQ = 4096, DEPTH = 2, T = BATCH * SEQ;
constexpr int MEM_LEN = 256, TM = BATCH * MEM_LEN;
constexpr int N_IN = 7448, N_INP = 7680;
constexpr int NEXP = 256, TOPK = 8, EDIM = 256;
constexpr float LN_EPS = 1e-5f;
constexpr float DN_ALPHA = 1.4142135623730951f;
constexpr float LOG2E = 1.4426950408889634f;
constexpr float QSC64 = 0.125f * LOG2E;
constexpr float QSC128 = 0.08838834764831845f * LOG2E;
constexpr int NHM = 40;
constexpr int NPAD_ROWS = T * TOPK + NEXP * 256;
constexpr int NBLK_MAX = NPAD_ROWS / 256;

constexpr size_t MiB = 1u << 20;
constexpr size_t CTL_BYTES = 1 * MiB;
constexpr size_t WL_WIN = 0;
constexpr size_t WL_W1C = WL_WIN + (size_t)N_INP * DM * 2;
constexpr size_t WL_W2C = WL_W1C + (size_t)2 * 256 * 2048 * 2;
constexpr size_t WL_WB = WL_W2C + (size_t)2 * 256 * 256 * 2;
constexpr size_t WL_WOUT = WL_WB + (size_t)3 * 1024 * 512 * 2;
constexpr size_t WL_WQ = WL_WOUT + (size_t)1024 * 1024 * 2;
constexpr size_t WL_WKV = WL_WQ + (size_t)512 * 1024 * 2;
constexpr size_t WL_WO = WL_WKV + (size_t)1024 * 1024 * 2;
constexpr size_t WL_WRS = WL_WO + (size_t)1024 * 512 * 2;
constexpr size_t WL_WS2 = WL_WRS + (size_t)768 * 1024 * 2;
constexpr size_t WL_W13 = WL_WS2 + (size_t)1024 * 256 * 2;
constexpr size_t WL_W2 = WL_W13 + (size_t)NEXP * 512 * 1024 * 2;
constexpr size_t WL_CB = WL_W2 + (size_t)NEXP * 1024 * 256 * 2;
constexpr size_t WL_BYTES = ((WL_CB + 2 * 256 * 4 + 4095) / 4096) * 4096;
constexpr size_t WS_W = CTL_BYTES;
constexpr size_t WS_ACT = WS_W + DEPTH * WL_BYTES;
constexpr size_t A_HF = 0;
constexpr size_t A_HB = A_HF + (size_t)T * DM * 4;
constexpr size_t A_HM = A_HB + (size_t)(T + 8) * DM * 2;
constexpr size_t A_CMP = A_HM + (size_t)BATCH * NHM * SEQ * 64 * 2;
constexpr size_t A_CONV = A_CMP + (size_t)BATCH * 4 * SEQ * 64 * 2 + 8192;
constexpr size_t A_MG = A_CONV + (size_t)T * 1536 * 2;
constexpr size_t A_NG = A_MG + (size_t)T * 3072 * 2;
constexpr size_t A_H1 = A_NG + (size_t)T * 24 * 4;
constexpr size_t A_CKV = A_H1 + (size_t)8192 * 256 * 2;
constexpr size_t A_KMEAN = A_CKV + (size_t)32 * 256 * 64 * 2;
constexpr size_t A_Y3 = A_KMEAN + (size_t)BATCH * 8 * 16 * 64 * 4;
constexpr size_t A_MERGED = A_Y3 + (size_t)3 * T * 512 * 2;
constexpr size_t A_DELTA = A_MERGED + (size_t)T * DM * 2;
constexpr size_t A_DELTAB = A_DELTA + (size_t)T * DM * 4;
constexpr size_t A_QX = A_DELTAB + (size_t)T * DM * 2;
constexpr size_t A_MEMB = A_QX + (size_t)T * 512 * 2;
constexpr size_t A_KVM = A_MEMB + (size_t)TM * DM * 2;
constexpr size_t A_OX = A_KVM + (size_t)DEPTH * TM * DM * 2;
constexpr size_t A_RS = A_OX + (size_t)T * 512 * 2;
constexpr size_t A_HS = A_RS + (size_t)T * 256 * 4;
constexpr size_t A_RIDX = A_HS + (size_t)T * 256 * 2;
constexpr size_t A_RW = A_RIDX + (size_t)T * 8 * 4;
constexpr size_t A_RRANK = A_RW + (size_t)T * 8 * 4;
constexpr size_t A_RPOS = A_RRANK + (size_t)T * 8 * 4;
constexpr size_t A_ROWW = A_RPOS + (size_t)T * 8 * 4;
constexpr size_t A_BLKE = A_ROWW + (size_t)NPAD_ROWS * 4;
constexpr size_t A_XG = A_BLKE + (size_t)(NBLK_MAX + 64) * 4;
constexpr size_t A_HE = A_XG + (size_t)NPAD_ROWS * DM * 2;
constexpr size_t A_END = A_HE + (size_t)NPAD_ROWS * 256 * 2;
constexpr size_t WS_END = WS_ACT + A_END;

constexpr int CW_BAR = 4096;
constexpr int CW_CNT = 16384;
constexpr int CW_GRP = 24576;

constexpr int RING_BYTES = 135168;
constexpr int LDSCTL_OFF = RING_BYTES, MISC_OFF = LDSCTL_OFF + 320;
constexpr int LDS_BYTES = 147456;
constexpr int NWAVES = 8;

#define GAS __attribute__((address_space(1)))
#define LAS __attribute__((address_space(3)))
typedef unsigned short bf16;
typedef unsigned v4u __attribute__((ext_vector_type(4)));
typedef unsigned v2u __attribute__((ext_vector_type(2)));
typedef float f32x4 __attribute__((ext_vector_type(4)));
typedef float f32x16 __attribute__((ext_vector_type(16)));
typedef short bf16x8 __attribute__((ext_vector_type(8)));
typedef short s16x4 __attribute__((ext_vector_type(4)));
#define LDS_WAIT() asm volatile("s_waitcnt lgkmcnt(0)" ::: "memory")
#define VM_WAIT() asm volatile("s_waitcnt vmcnt(0)" ::: "memory")
__device__ __forceinline__ unsigned f2bf(float f) { unsigned u = __builtin_bit_cast(unsigned, f); return (u + 0x7fffu + ((u >> 16) & 1u)) >> 16; }
__device__ __forceinline__ unsigned pk2(float lo, float hi) { return f2bf(lo) | (f2bf(hi) << 16); }
__device__ __forceinline__ float bf2f(unsigned short b) { return __builtin_bit_cast(float, ((unsigned)b) << 16); }
__device__ __forceinline__ float bflo(unsigned w) { return __builtin_bit_cast(float, w << 16); }
__device__ __forceinline__ float bfhi(unsigned w) { return __builtin_bit_cast(float, w & 0xffff0000u); }
__device__ __forceinline__ float sigmoidf_(float x) { return 1.0f / (1.0f + __expf(-x)); }
__device__ __forceinline__ float gelu_tanh(float x) { const float y = 0.7978845608028654f * (x + 0.044715f * x * x * x); const float e = __expf(2.0f * y); const float th = 1.0f - 2.0f / (e + 1.0f); return 0.5f * x * (1.0f + th); }

__device__ __forceinline__ int lane_now() { int l; asm volatile("v_mbcnt_lo_u32_b32 %0, -1, 0\n\tv_mbcnt_hi_u32_b32 %0, -1, %0" : "=v"(l)); return l; }
#define XB_TMO      128
#define XB_XCNT(j)  (256  + 64 * (j))
#define XB_XSUB(j)  (1280 + 64 * (j))
#define XB_XGEN(j)  (2304 + 64 * (j))
#define XB_TOP      3328
#define XB_TOPGEN   3392
#define XCD_BAR_WORDS 3456
#define XB_SPIN_CAP (1u << 18)
__device__ __forceinline__ unsigned xb_ld(unsigned* p)              { return __hip_atomic_load(p, __ATOMIC_RELAXED, __HIP_MEMORY_SCOPE_AGENT); }
__device__ __forceinline__ unsigned xb_add(unsigned* p, unsigned v) { return __hip_atomic_fetch_add(p, v, __ATOMIC_RELAXED, __HIP_MEMORY_SCOPE_AGENT); }
__device__ __forceinline__ unsigned xb_xcc_id() { return (unsigned)__builtin_amdgcn_s_getreg((3 << 11) | 20) & 0xFu; }
#define XB_SPIN(cond, bar) do { unsigned _sp = 0; while (cond) { __builtin_amdgcn_s_sleep(1); \
    if ((++_sp & 255u) == 0u) { if (xb_ld(&(bar)[XB_TMO])) break; if (_sp > XB_SPIN_CAP) { atomicAdd(&(bar)[XB_TMO], 1u); break; } } } } while (0)
struct XcdBarrier { unsigned* bar; unsigned x; volatile LAS unsigned* st; };
__device__ __forceinline__ XcdBarrier xcd_barrier_post(unsigned* bar, volatile LAS unsigned* st, bool leader) {
    XcdBarrier b; b.bar = bar; b.x = xb_xcc_id(); b.st = st;
    if (leader) (void)xb_add(&bar[XB_XCNT(b.x)], 1u);
    return b;
}
__device__ __forceinline__ void xcd_barrier_complete(unsigned* bar, unsigned x, unsigned& nloc, unsigned& nx) {
    const unsigned G = gridDim.x * gridDim.y * gridDim.z;
    unsigned sum, cnt, mine, sp = 0u;
    for (;;) {
        sum = 0u; cnt = 0u; mine = 0u;
#pragma unroll
        for (unsigned j = 0; j < 16; ++j) { const unsigned c = xb_ld(&bar[XB_XCNT(j)]); sum += c; cnt += (c > 0u) ? 1u : 0u; mine = (j == x) ? c : mine; }
        if (sum == G) break;
        __builtin_amdgcn_s_sleep(1);
        if ((++sp & 255u) == 0u) { if (xb_ld(&bar[XB_TMO])) break; if (sp > XB_SPIN_CAP) { atomicAdd(&bar[XB_TMO], 1u); break; } }
    }
    nloc = mine > 0u ? mine : 1u; nx = cnt > 0u ? cnt : 1u;
}
__device__ __forceinline__ void xcd_barrier(const XcdBarrier& b, bool leader) {
    asm volatile("s_waitcnt vmcnt(0)" ::: "memory");
    __syncthreads();
    if (leader) {
        unsigned* bar = b.bar; asm volatile("" : "+s"(bar));
        __builtin_amdgcn_s_waitcnt(0);
        unsigned nloc = b.st[0], nx = b.st[1];
        if (nloc == 0u) { xcd_barrier_complete(bar, b.x, nloc, nx); b.st[0] = nloc; b.st[1] = nx; }
        const unsigned old = xb_add(&bar[XB_XSUB(b.x)], 1u);
        const unsigned gen = old / nloc;
        if (old + 1u == (gen + 1u) * nloc) {
            __builtin_amdgcn_fence(__ATOMIC_RELEASE, "agent");
            asm volatile("s_waitcnt vmcnt(0)" ::: "memory");
            const unsigned og = xb_add(&bar[XB_TOP], 1u);
            const unsigned tg = og / nx;
            if (og + 1u == (tg + 1u) * nx) xb_add(&bar[XB_TOPGEN], 1u);
            else XB_SPIN(xb_ld(&bar[XB_TOPGEN]) == tg, bar);
            __builtin_amdgcn_fence(__ATOMIC_ACQUIRE, "agent");
            xb_add(&bar[XB_XGEN(b.x)], 1u);
            asm volatile("s_waitcnt vmcnt(0)" ::: "memory");
        } else {
            XB_SPIN(xb_ld(&bar[XB_XGEN(b.x)]) == gen, bar);
            __builtin_amdgcn_fence(__ATOMIC_ACQUIRE, "agent");
            asm volatile("s_waitcnt vmcnt(0)" ::: "memory");
        }
    }
    __syncthreads();
}

namespace pg8 {
#define PG8_LAS __attribute__((address_space(3)))
typedef unsigned short bf16_t;
typedef unsigned u32x4 __attribute__((ext_vector_type(4)));
constexpr int BM = 256, BK = 64, HALF = 128, HTB = HALF * BK * 2, STAGE_BYTES = 8 * HTB, NXCD = 8, WGM = 8;
__host__ __device__ __forceinline__ int lds_byte(int r, int c) { const int st = (r >> 4) * 2 + (c >> 5), rr = r & 15, cc = c & 31, ob = rr * 64 + cc * 2; return st * 1024 + (ob ^ (((ob >> 9) & 1) << 5)); }
__host__ __device__ __forceinline__ void stage_rc(int b, int& R, int& C) { const int st = b / 1024, sb = b % 1024, swz = sb ^ (((sb >> 9) & 1) << 5); R = (st >> 1) * 16 + swz / 64; C = (st & 1) * 32 + (swz % 64) / 2; }
__host__ __device__ __forceinline__ int perm32(int rho) { const int n = rho >> 4, i = rho & 15; return 8 * (i >> 2) + 4 * n + (i & 3); }
struct Unit { int pm, pn; int aux; };
struct Gemm { const bf16_t* A; const bf16_t* Bt; int lda, K; const int* gidx; };
struct StaticOrder {
    int nM, nN, nwg, G, c, i0, imax;
    __host__ __device__ void init(int M, int N, int G_, int c_) { nM = M / BM; nN = N / BM; nwg = nM * nN; G = G_; c = c_; i0 = 0; imax = 1 << 30; }
    __host__ __device__ bool next(int i, Unit& u) const {
        if (i >= imax) return false;
        const long L = (long)(i0 + i) * G + c; if (L >= nwg) return false;
        int wgid = (int)L; { const int q = nwg / NXCD, r = nwg % NXCD, xcd = wgid % NXCD, off = wgid / NXCD; wgid = (xcd < r ? xcd * (q + 1) : r * (q + 1) + (xcd - r) * q) + off; }
        const int nig = WGM * nN, gid = wgid / nig, fm = gid * WGM, gsz = (nM - fm) < WGM ? (nM - fm) : WGM;
        u.pm = fm + ((wgid % nig) % gsz); u.pn = (wgid % nig) / gsz; return true;
    }
};
__device__ __forceinline__ unsigned cvt_pk_bf16(float lo, float hi) { unsigned r; asm volatile("v_cvt_pk_bf16_f32 %0, %1, %2" : "=v"(r) : "v"(lo), "v"(hi)); return r; }

template <class Epi, class Sched, bool ALIGN_EPI = true, bool SP2 = true, bool GATHER = false>
__device__ __forceinline__ void gemm_phase(PG8_LAS unsigned char* lds, const Gemm g, const Sched& S, const Epi& E, int wave0) {
    int tid_ = (wave0 << 6) | lane_now(); asm volatile("" : "+v"(tid_));
    const int tid = tid_, wid = __builtin_amdgcn_readfirstlane(tid >> 6), lane = tid & 63, wr = wid >> 2, wc = wid & 3, fr = lane & 15, fq = lane >> 4;
    int K_ = g.K; asm volatile("" : "+s"(K_));
    const int K = K_, nt = K / BK, lda = g.lda;
    static_assert(!GATHER || SP2, "gather needs the SP2 loop");
    unsigned voffA[2], voffB[2];
#pragma unroll
    for (int i = 0; i < 2; ++i) { int R, C; stage_rc(tid * 16 + i * 8192, R, C); const int Rb = Epi::PERM ? ((R & ~31) + perm32(R & 31)) : R;
        voffA[i] = (unsigned)(R * lda + C) * 2u; voffB[i] = (unsigned)(Rb * K + C) * 2u; }
    unsigned gA[2][2];
#define PG8_GLOAD(dst, pm_) do { int tq_ = tid; asm volatile("" : "+v"(tq_)); const char* gb_ = (const char*)g.gidx + (size_t)(pm_) * 1024; \
        _Pragma("unroll") for (int i_ = 0; i_ < 2; ++i_) { int R_, C_; stage_rc(tq_ * 16 + i_ * 8192, R_, C_); _Pragma("unroll") for (int h_ = 0; h_ < 2; ++h_) \
        dst[h_][i_] = ((unsigned)(*(const int*)(gb_ + (unsigned)((h_ * 128 + R_) * 4))) * (unsigned)lda + (unsigned)C_) * 2u; } } while (0)
    const size_t kstep = (size_t)(BK * 2);
    const size_t hstepA = (size_t)HALF * lda * 2, hstepB = (size_t)HALF * K * 2;
    const size_t tstepA = 2 * hstepA, tstepB = 2 * hstepB;
    const unsigned ldsw = (unsigned)wid * 1024u;
    const int aoff = lds_byte(wr * 64 + fr, fq * 8), boff = lds_byte(wc * 32 + fr, fq * 8);
#define PG8_SA(b, h) (((b) * 2 + (h)) * HTB)
#define PG8_SB(b, h) ((4 + (b) * 2 + (h)) * HTB)
#define PG8_STAGE(bufoff, gbase, voff) do { _Pragma("unroll") for (int _i = 0; _i < 2; ++_i) \
        __builtin_amdgcn_global_load_lds((const unsigned*)((const char*)(gbase) + (voff)[_i]), (PG8_LAS unsigned*)(lds + (bufoff) + ldsw + _i * 8192), 16, 0, 0); } while (0)
#define PG8_LDA(dst, b, h) do { _Pragma("unroll") for (int m = 0; m < 4; ++m) _Pragma("unroll") for (int k = 0; k < 2; ++k) dst[m][k] = *(const PG8_LAS bf16x8*)(lds + PG8_SA(b, h) + aoff + m * 2048 + k * 1024); } while (0)
#define PG8_LDB(dst, b, h) do { _Pragma("unroll") for (int n = 0; n < 2; ++n) _Pragma("unroll") for (int k = 0; k < 2; ++k) dst[n][k] = *(const PG8_LAS bf16x8*)(lds + PG8_SB(b, h) + boff + n * 2048 + k * 1024); } while (0)
#define PG8_MMA(ai, bj, At, Bt) do { __builtin_amdgcn_s_setprio(1); _Pragma("unroll") for (int m = 0; m < 4; ++m) _Pragma("unroll") for (int n = 0; n < 2; ++n) _Pragma("unroll") for (int k = 0; k < 2; ++k) \
        acc[ai][bj][m][n] = __builtin_amdgcn_mfma_f32_16x16x32_bf16(Bt[n][k], At[m][k], acc[ai][bj][m][n], 0, 0, 0); __builtin_amdgcn_s_setprio(0); } while (0)
#define PG8_WAIT_V(n) asm volatile("s_waitcnt vmcnt(" #n ")" ::: "memory")
#define PG8_WAIT_L(n) asm volatile("s_waitcnt lgkmcnt(" #n ")" ::: "memory")
#define PG8_BAR __builtin_amdgcn_s_barrier()
#define PG8_SCHED __builtin_amdgcn_sched_barrier(0)
    Unit cur, nxt; int ui = 0;
    if (!S.next(0, cur)) return;
    f32x4 acc[2][2][4][2];
#pragma unroll
    for (int a = 0; a < 2; ++a)
#pragma unroll
        for (int b = 0; b < 2; ++b)
#pragma unroll
            for (int m = 0; m < 4; ++m)
#pragma unroll
                for (int n = 0; n < 2; ++n) acc[a][b][m][n] = (f32x4){0.f, 0.f, 0.f, 0.f};
    bf16x8 At[4][2], B0[2][2], B1[2][2];
    const char* cA = (const char*)g.A + (GATHER ? (size_t)0 : (size_t)cur.pm * tstepA); const char* cB = (const char*)g.Bt + (size_t)cur.pn * tstepB;
    if constexpr (GATHER) { PG8_GLOAD(gA, cur.pm); }
    if constexpr (SP2) {
        PG8_STAGE(PG8_SB(0, 0), cB, voffB); PG8_STAGE(PG8_SB(0, 1), cB + hstepB, voffB); if constexpr (GATHER) { PG8_STAGE(PG8_SA(0, 0), cA, gA[0]); PG8_STAGE(PG8_SA(0, 1), cA, gA[1]); } else { PG8_STAGE(PG8_SA(0, 0), cA, voffA); PG8_STAGE(PG8_SA(0, 1), cA + hstepA, voffA); }
        if (wr == 1) PG8_BAR;
        PG8_WAIT_V(2); PG8_BAR;
        PG8_STAGE(PG8_SB(1, 0), cB + kstep, voffB); if constexpr (GATHER) { PG8_STAGE(PG8_SA(1, 0), cA + kstep, gA[0]); } else { PG8_STAGE(PG8_SA(1, 0), cA + kstep, voffA); } PG8_STAGE(PG8_SB(1, 1), cB + hstepB + kstep, voffB);
        PG8_WAIT_V(6); PG8_BAR;
    } else {
        PG8_STAGE(PG8_SB(0, 0), cB, voffB); PG8_STAGE(PG8_SA(0, 0), cA, voffA); PG8_STAGE(PG8_SB(0, 1), cB + hstepB, voffB); PG8_STAGE(PG8_SA(0, 1), cA + hstepA, voffA);
        if (wr == 1) PG8_BAR;
        PG8_WAIT_V(4); PG8_BAR;
        PG8_STAGE(PG8_SB(1, 0), cB + kstep, voffB); PG8_STAGE(PG8_SA(1, 0), cA + kstep, voffA); PG8_STAGE(PG8_SB(1, 1), cB + hstepB + kstep, voffB);
        PG8_WAIT_V(6); PG8_BAR;
    }
    for (;;) {
        const bool has_next = S.next(ui + 1, nxt);
        const char* nA = (has_next && !GATHER) ? (const char*)g.A + (size_t)nxt.pm * tstepA : cA; const char* nB = has_next ? (const char*)g.Bt + (size_t)nxt.pn * tstepB : cB;
        unsigned o2[2][2];
        for (int t = 0; t < nt; t += 2) {
            const bool last = (t == nt - 2);
            const char* a1 = cA + (size_t)(t + 1) * kstep;
            const char* a2 = last ? nA : cA + (size_t)(t + 2) * kstep; const char* b2 = last ? nB : cB + (size_t)(t + 2) * kstep;
            const char* a3 = a2 + kstep; const char* b3 = b2 + kstep;
            if constexpr (Epi::MID) { if (t == 8 || t == 16) E.mid(acc, cur, t >> 3, wr, wc, fr, fq); }
            if constexpr (SP2) {
            if constexpr (GATHER) { if (last && has_next) { PG8_GLOAD(o2, nxt.pm); } else {
#pragma unroll
                for (int h_ = 0; h_ < 2; ++h_) { o2[h_][0] = gA[h_][0]; o2[h_][1] = gA[h_][1]; } } }
            PG8_LDB(B0, 0, 0); PG8_LDB(B1, 0, 1); PG8_SCHED; PG8_LDA(At, 0, 0); if constexpr (GATHER) { PG8_STAGE(PG8_SA(1, 1), a1, gA[1]); } else { PG8_STAGE(PG8_SA(1, 1), a1 + hstepA, voffA); }
            PG8_WAIT_V(8); PG8_WAIT_L(0); PG8_BAR; PG8_MMA(0, 0, At, B0); PG8_MMA(0, 1, At, B1); PG8_BAR; PG8_SCHED;
            PG8_LDA(At, 0, 1); PG8_STAGE(PG8_SB(0, 0), b2, voffB); PG8_STAGE(PG8_SB(0, 1), b2 + hstepB, voffB); if constexpr (GATHER) { PG8_STAGE(PG8_SA(0, 0), a2, o2[0]); } else { PG8_STAGE(PG8_SA(0, 0), a2, voffA); }
            PG8_WAIT_V(8); PG8_WAIT_L(0); PG8_BAR; PG8_MMA(1, 0, At, B0); PG8_MMA(1, 1, At, B1); PG8_BAR; PG8_SCHED;
            PG8_LDB(B0, 1, 0); PG8_LDB(B1, 1, 1); PG8_SCHED; PG8_LDA(At, 1, 0); if constexpr (GATHER) { PG8_STAGE(PG8_SA(0, 1), a2, o2[1]); } else { PG8_STAGE(PG8_SA(0, 1), a2 + hstepA, voffA); }
            PG8_WAIT_V(8); PG8_WAIT_L(0); PG8_BAR; PG8_MMA(0, 0, At, B0); PG8_MMA(0, 1, At, B1); PG8_BAR; PG8_SCHED;
            PG8_LDA(At, 1, 1); PG8_STAGE(PG8_SB(1, 0), b3, voffB); PG8_STAGE(PG8_SB(1, 1), b3 + hstepB, voffB); if constexpr (GATHER) { PG8_STAGE(PG8_SA(1, 0), a3, o2[0]); } else { PG8_STAGE(PG8_SA(1, 0), a3, voffA); }
            PG8_WAIT_V(8); PG8_WAIT_L(0); PG8_BAR; PG8_MMA(1, 0, At, B0); PG8_MMA(1, 1, At, B1); PG8_BAR; PG8_SCHED;
            } else {
            PG8_LDB(B0, 0, 0); PG8_SCHED; PG8_LDA(At, 0, 0); PG8_STAGE(PG8_SA(1, 1), a1 + hstepA, voffA);
            PG8_WAIT_L(8); PG8_BAR; PG8_WAIT_L(0); PG8_MMA(0, 0, At, B0); PG8_BAR; PG8_SCHED;
            PG8_LDB(B1, 0, 1); PG8_STAGE(PG8_SB(0, 0), b2, voffB);
            PG8_BAR; PG8_WAIT_L(0); PG8_MMA(0, 1, At, B1); PG8_BAR;
            PG8_LDA(At, 0, 1); PG8_STAGE(PG8_SA(0, 0), a2, voffA);
            PG8_BAR; PG8_WAIT_L(0); PG8_MMA(1, 0, At, B0); PG8_BAR; PG8_SCHED;
            PG8_STAGE(PG8_SB(0, 1), b2 + hstepB, voffB);
            PG8_WAIT_V(6); PG8_BAR; PG8_MMA(1, 1, At, B1); PG8_BAR;
            PG8_LDB(B0, 1, 0); PG8_SCHED; PG8_LDA(At, 1, 0); PG8_STAGE(PG8_SA(0, 1), a2 + hstepA, voffA);
            PG8_WAIT_L(8); PG8_BAR; PG8_WAIT_L(0); PG8_MMA(0, 0, At, B0); PG8_BAR; PG8_SCHED;
            PG8_LDB(B1, 1, 1); PG8_STAGE(PG8_SB(1, 0), b3, voffB);
            PG8_BAR; PG8_WAIT_L(0); PG8_MMA(0, 1, At, B1); PG8_BAR;
            PG8_LDA(At, 1, 1); PG8_STAGE(PG8_SA(1, 0), a3, voffA);
            PG8_BAR; PG8_WAIT_L(0); PG8_MMA(1, 0, At, B0); PG8_BAR; PG8_SCHED;
            PG8_STAGE(PG8_SB(1, 1), b3 + hstepB, voffB);
            PG8_WAIT_V(6); PG8_BAR; PG8_MMA(1, 1, At, B1); PG8_BAR;
            }
        }
        if constexpr (ALIGN_EPI) { if (wr == 0) PG8_BAR; }
        E(acc, cur, wr, wc, fr, fq);
        if (!has_next) break;
#pragma unroll
        for (int a = 0; a < 2; ++a)
#pragma unroll
            for (int b = 0; b < 2; ++b)
#pragma unroll
                for (int m = 0; m < 4; ++m)
#pragma unroll
                    for (int n = 0; n < 2; ++n) acc[a][b][m][n] = (f32x4){0.f, 0.f, 0.f, 0.f};
        cur = nxt; cA = nA; cB = nB; ++ui;
        if constexpr (GATHER) {
#pragma unroll
            for (int h_ = 0; h_ < 2; ++h_) { gA[h_][0] = o2[h_][0]; gA[h_][1] = o2[h_][1]; } }
        if constexpr (ALIGN_EPI) { if (wr == 1) PG8_BAR; }
    }
    PG8_WAIT_V(0);
    if constexpr (!ALIGN_EPI) { if (wr == 0) PG8_BAR; }
    PG8_BAR;
#undef PG8_GLOAD
#undef PG8_SA
#undef PG8_SB
#undef PG8_STAGE
#undef PG8_LDA
#undef PG8_LDB
#undef PG8_MMA
#undef PG8_WAIT_V
#undef PG8_WAIT_L
#undef PG8_BAR
#undef PG8_SCHED
}
}
using pg8::Unit; using pg8::cvt_pk_bf16; using pg8::u32x4;
typedef const f32x4 (&AccRef)[2][2][4][2];

__device__ __forceinline__ void grp_barrier(unsigned* bar, unsigned* gword, unsigned n, bool leader) {
    asm volatile("s_waitcnt vmcnt(0)" ::: "memory");
    __syncthreads();
    if (leader) {
        __builtin_amdgcn_fence(__ATOMIC_RELEASE, "agent");
        asm volatile("s_waitcnt vmcnt(0)" ::: "memory");
        const unsigned old = xb_add(gword, 1u);
        const unsigned target = (old / n + 1u) * n;
        XB_SPIN(xb_ld(gword) < target, bar);
        __builtin_amdgcn_fence(__ATOMIC_ACQUIRE, "agent");
        asm volatile("s_waitcnt vmcnt(0)" ::: "memory");
    }
    __syncthreads();
}
struct SchedCmp {
    int G, c;
    __device__ bool next(int i, Unit& u) const { const int L = i * G + c; if (L >= 32) return false; u.pm = L; u.pn = (L >> 1) & 1; return true; }
};
struct SchedOpt { int pm, pn; bool ok; __device__ bool next(int i, Unit& u) const { if (i || !ok) return false; u.pm = pm; u.pn = pn; return true; } };
struct SchedGrouped {
    int G, c, nct, NB; const LAS int* blk_e;
    __device__ bool next(int i, Unit& u) const { const int L = i * G + c; if (L >= NB * nct) return false; const int rb = L / nct, ct = L - rb * nct; const int v = __builtin_amdgcn_readfirstlane(blk_e[rb]); u.pm = rb; u.pn = (v & 0xffff) * nct + ct; u.aux = v >> 16; return true; }
};

struct EpiX { int fr2, fq2, pa; __device__ __forceinline__ EpiX(int fr, int fq) { const int ln = fq * 16 + fr; fr2 = ln >> 2; fq2 = ln & 3; pa = ((fq2 << 4) | fr2) << 2; }
    __device__ __forceinline__ u32x4 operator()(u32x4 w) const { u32x4 r; r.x = (unsigned)__builtin_amdgcn_ds_bpermute(pa, (int)w.x); r.y = (unsigned)__builtin_amdgcn_ds_bpermute(pa, (int)w.y);
        r.z = (unsigned)__builtin_amdgcn_ds_bpermute(pa, (int)w.z); r.w = (unsigned)__builtin_amdgcn_ds_bpermute(pa, (int)w.w); return r; } };
struct EpiWin {
    static constexpr bool PERM = true, MID = false;
    bf16* HM; bf16* CMP; bf16* CONV; bf16* MG; float* NG;
    __device__ __forceinline__ void operator()(AccRef acc, const Unit& u, int wr, int wc, int fr, int fq) const {
        const int pn = u.pn; const EpiX X(fr, fq);
#pragma unroll
        for (int ai = 0; ai < 2; ++ai)
#pragma unroll
            for (int m = 0; m < 4; ++m) {
                const int t = u.pm * 256 + ai * 128 + wr * 64 + m * 16 + ((pn < 29) ? X.fr2 : fr); const int b = t >> 12, s = t & 4095;
#pragma unroll
                for (int bj = 0; bj < 2; ++bj) {
                    const int c8 = bj * 128 + wc * 32 + ((pn < 29) ? X.fq2 : fq) * 8;
                    f32x4 v0 = acc[ai][bj][m][0], v1 = acc[ai][bj][m][1];
                    if (pn < 11) {
                        const int hh = c8 >> 6, d = c8 & 63; bf16* dst;
                        if (pn < 10) { const int head = pn * 4 + hh; const float sc = (head < 8 || (head >= 16 && head < 24)) ? QSC64 : 1.0f; v0 = v0 * sc; v1 = v1 * sc;
                            dst = HM + ((size_t)(b * NHM + head) * SEQ + s) * 64 + d; }
                        else dst = CMP + ((size_t)(b * 4 + hh) * SEQ + s) * 64 + d;
                        u32x4 w; w.x = cvt_pk_bf16(v0[0], v0[1]); w.y = cvt_pk_bf16(v0[2], v0[3]); w.z = cvt_pk_bf16(v1[0], v1[1]); w.w = cvt_pk_bf16(v1[2], v1[3]);
                        *(u32x4*)dst = X(w);
                    } else if (pn < 17) {
                        u32x4 w; w.x = cvt_pk_bf16(v0[0], v0[1]); w.y = cvt_pk_bf16(v0[2], v0[3]); w.z = cvt_pk_bf16(v1[0], v1[1]); w.w = cvt_pk_bf16(v1[2], v1[3]);
                        *(u32x4*)(CONV + (size_t)t * 1536 + (pn - 11) * 256 + c8) = X(w);
                    } else if (pn < 29) {
#pragma unroll
                        for (int j = 0; j < 4; ++j) { v0[j] = sigmoidf_(v0[j]); v1[j] = sigmoidf_(v1[j]); }
                        u32x4 w; w.x = cvt_pk_bf16(v0[0], v0[1]); w.y = cvt_pk_bf16(v0[2], v0[3]); w.z = cvt_pk_bf16(v1[0], v1[1]); w.w = cvt_pk_bf16(v1[2], v1[3]);
                        *(u32x4*)(MG + ((size_t)((u.pm * 16 + ai * 8 + wr * 4 + m) * 96 + (pn - 17) * 8 + bj * 4 + wc) * 64 + (fq * 16 + fr)) * 8) = w;
                    } else {
                        if (c8 < 24) {
#pragma unroll
                            for (int j = 0; j < 4; ++j) { v0[j] = sigmoidf_(v0[j]); v1[j] = sigmoidf_(v1[j]); }
                            *(f32x4*)(NG + (size_t)t * 24 + c8) = v0; *(f32x4*)(NG + (size_t)t * 24 + c8 + 4) = v1;
                        }
                    }
                }
            }
    }
};
struct EpiBf16 {
    static constexpr bool PERM = true, MID = false;
    bf16* O; int ldc; float scale;
    __device__ __forceinline__ void operator()(AccRef acc, const Unit& u, int wr, int wc, int fr, int fq) const {
        const EpiX X(fr, fq);
#pragma unroll
        for (int ai = 0; ai < 2; ++ai)
#pragma unroll
            for (int m = 0; m < 4; ++m) { bf16* rowp = O + (size_t)(u.pm * 256 + ai * 128 + wr * 64 + m * 16 + X.fr2) * ldc + u.pn * 256 + wc * 32 + X.fq2 * 8;
#pragma unroll
                for (int bj = 0; bj < 2; ++bj) { const f32x4 v0 = acc[ai][bj][m][0] * scale, v1 = acc[ai][bj][m][1] * scale;
                    u32x4 w; w.x = cvt_pk_bf16(v0[0], v0[1]); w.y = cvt_pk_bf16(v0[2], v0[3]); w.z = cvt_pk_bf16(v1[0], v1[1]); w.w = cvt_pk_bf16(v1[2], v1[3]);
                    *(u32x4*)(rowp + bj * 128) = X(w); } }
    }
};
struct EpiCmp1 {
    static constexpr bool PERM = true, MID = false;
    bf16* H1; const float* bias;
    __device__ __forceinline__ void operator()(AccRef acc, const Unit& u, int wr, int wc, int fr, int fq) const {
        const float* bi = bias + ((u.pm >> 1) & 1) * 256;
#pragma unroll
        for (int bj = 0; bj < 2; ++bj) { const int c8 = bj * 128 + wc * 32 + fq * 8; const f32x4 b0 = *(const f32x4*)(bi + c8), b1 = *(const f32x4*)(bi + c8 + 4);
#pragma unroll
            for (int ai = 0; ai < 2; ++ai)
#pragma unroll
                for (int m = 0; m < 4; ++m) { f32x4 v0 = acc[ai][bj][m][0] + b0, v1 = acc[ai][bj][m][1] + b1;
#pragma unroll
                    for (int j = 0; j < 4; ++j) { v0[j] = gelu_tanh(v0[j]); v1[j] = gelu_tanh(v1[j]); }
                    u32x4 w; w.x = cvt_pk_bf16(v0[0], v0[1]); w.y = cvt_pk_bf16(v0[2], v0[3]); w.z = cvt_pk_bf16(v1[0], v1[1]); w.w = cvt_pk_bf16(v1[2], v1[3]);
                    *(u32x4*)(H1 + (size_t)(u.pm * 256 + ai * 128 + wr * 64 + m * 16 + fr) * 256 + c8) = w; } }
    }
};
struct EpiCmp2 {
    static constexpr bool PERM = true, MID = false;
    bf16* CKV;
    __device__ __forceinline__ void operator()(AccRef acc, const Unit& u, int wr, int wc, int fr, int fq) const {
        if (wc < 2) {
            const int c8 = wc * 32 + fq * 8;
#pragma unroll
            for (int ai = 0; ai < 2; ++ai)
#pragma unroll
                for (int m = 0; m < 4; ++m) { const f32x4 v0 = acc[ai][0][m][0], v1 = acc[ai][0][m][1];
                    u32x4 w; w.x = cvt_pk_bf16(v0[0], v0[1]); w.y = cvt_pk_bf16(v0[2], v0[3]); w.z = cvt_pk_bf16(v1[0], v1[1]); w.w = cvt_pk_bf16(v1[2], v1[3]);
                    *(u32x4*)(CKV + ((size_t)u.pm * 256 + ai * 128 + wr * 64 + m * 16 + fr) * 64 + c8) = w; }
        }
    }
};
struct EpiMergeK {
    static constexpr bool PERM = true, MID = true;
    const bf16* MG; bf16* MERGED;
    __device__ __forceinline__ void gate8(f32x4& a, f32x4& b, int t16, int c32, int ln) const { const v4u w = *(const v4u*)(MG + ((size_t)(t16 * 96 + c32) * 64 + ln) * 8);
        a = (f32x4){bflo(w.x), bfhi(w.x), bflo(w.y), bfhi(w.y)}; b = (f32x4){bflo(w.z), bfhi(w.z), bflo(w.w), bfhi(w.w)}; }
    __device__ __forceinline__ void mid(f32x4 (&acc)[2][2][4][2], const Unit& u, int seg, int wr, int wc, int fr, int fq) const {
#pragma unroll
        for (int ai = 0; ai < 2; ++ai)
#pragma unroll
            for (int m = 0; m < 4; ++m) {
#pragma unroll
                for (int bj = 0; bj < 2; ++bj) { const unsigned ob = (unsigned)(((u.pm * 16 + ai * 8 + wr * 4 + m) * 96 + (seg - 1) * 32 + u.pn * 8 + bj * 4 + wc) * 64 + (fq * 16 + fr)) * 16u;
                    const v4u wn = *(const v4u*)((const char*)MG + ob), wd = *(const v4u*)((const char*)MG + ob + 32768u);
                    acc[ai][bj][m][0][0] *= bflo(wn.x) * __builtin_amdgcn_rcpf(bflo(wd.x)); acc[ai][bj][m][0][1] *= bfhi(wn.x) * __builtin_amdgcn_rcpf(bfhi(wd.x));
                    acc[ai][bj][m][0][2] *= bflo(wn.y) * __builtin_amdgcn_rcpf(bflo(wd.y)); acc[ai][bj][m][0][3] *= bfhi(wn.y) * __builtin_amdgcn_rcpf(bfhi(wd.y));
                    acc[ai][bj][m][1][0] *= bflo(wn.z) * __builtin_amdgcn_rcpf(bflo(wd.z)); acc[ai][bj][m][1][1] *= bfhi(wn.z) * __builtin_amdgcn_rcpf(bfhi(wd.z));
                    acc[ai][bj][m][1][2] *= bflo(wn.w) * __builtin_amdgcn_rcpf(bflo(wd.w)); acc[ai][bj][m][1][3] *= bfhi(wn.w) * __builtin_amdgcn_rcpf(bfhi(wd.w));
                    asm volatile("" ::: "memory"); } }
    }
    __device__ __forceinline__ void operator()(AccRef acc, const Unit& u, int wr, int wc, int fr, int fq) const {
        const EpiX X(fr, fq);
#pragma unroll
        for (int ai = 0; ai < 2; ++ai)
#pragma unroll
            for (int m = 0; m < 4; ++m) { const int t = u.pm * 256 + ai * 128 + wr * 64 + m * 16 + fr;
#pragma unroll
                for (int bj = 0; bj < 2; ++bj) { const int col = u.pn * 256 + bj * 128 + wc * 32 + fq * 8; f32x4 g0, g1; gate8(g0, g1, u.pm * 16 + ai * 8 + wr * 4 + m, 64 + u.pn * 8 + bj * 4 + wc, fq * 16 + fr);
                    const f32x4 v0 = acc[ai][bj][m][0] * g0, v1 = acc[ai][bj][m][1] * g1;
                    u32x4 w; w.x = cvt_pk_bf16(v0[0], v0[1]); w.y = cvt_pk_bf16(v0[2], v0[3]); w.z = cvt_pk_bf16(v1[0], v1[1]); w.w = cvt_pk_bf16(v1[2], v1[3]);
                    *(u32x4*)(MERGED + (size_t)(t - fr + X.fr2) * DM + col + (X.fq2 - fq) * 8) = X(w); }
                asm volatile("" ::: "memory"); }
    }
};
struct EpiRS {
    static constexpr bool PERM = true, MID = false;
    float* RS; bf16* HS;
    __device__ __forceinline__ void operator()(AccRef acc, const Unit& u, int wr, int wc, int fr, int fq) const {
        const EpiX X(fr, fq);
#pragma unroll
        for (int ai = 0; ai < 2; ++ai)
#pragma unroll
            for (int m = 0; m < 4; ++m) { const int t = u.pm * 256 + ai * 128 + wr * 64 + m * 16 + fr;
                if (u.pn == 0) {
#pragma unroll
                    for (int bj = 0; bj < 2; ++bj) { float* p = RS + (size_t)t * 256 + bj * 128 + wc * 32 + fq * 8; *(f32x4*)p = acc[ai][bj][m][0]; *(f32x4*)(p + 4) = acc[ai][bj][m][1]; }
                } else {
                    f32x4 h0, h1;
#pragma unroll
                    for (int j = 0; j < 4; ++j) { const float a0 = acc[ai][0][m][0][j], a1 = acc[ai][0][m][1][j]; h0[j] = a0 * sigmoidf_(a0) * acc[ai][1][m][0][j]; h1[j] = a1 * sigmoidf_(a1) * acc[ai][1][m][1][j]; }
                    u32x4 w; w.x = cvt_pk_bf16(h0[0], h0[1]); w.y = cvt_pk_bf16(h0[2], h0[3]); w.z = cvt_pk_bf16(h1[0], h1[1]); w.w = cvt_pk_bf16(h1[2], h1[3]);
                    *(u32x4*)(HS + (size_t)(t - fr + X.fr2) * 256 + (u.pn - 1) * 128 + wc * 32 + X.fq2 * 8) = X(w);
                }
            }
    }
};
struct EpiE1 {
    static constexpr bool PERM = true, MID = false;
    bf16* HE;
    __device__ __forceinline__ void operator()(AccRef acc, const Unit& u, int wr, int wc, int fr, int fq) const {
        const int ct = u.pn & 1; const EpiX X(fr, fq);
#pragma unroll
        for (int ai = 0; ai < 2; ++ai)
#pragma unroll
            for (int m = 0; m < 4; ++m) { const size_t row = (size_t)u.pm * 256 + ai * 128 + wr * 64 + m * 16 + X.fr2;
                f32x4 h0, h1;
#pragma unroll
                for (int j = 0; j < 4; ++j) { const float a0 = acc[ai][0][m][0][j], a1 = acc[ai][0][m][1][j]; h0[j] = a0 * sigmoidf_(a0) * acc[ai][1][m][0][j]; h1[j] = a1 * sigmoidf_(a1) * acc[ai][1][m][1][j]; }
                u32x4 w; w.x = cvt_pk_bf16(h0[0], h0[1]); w.y = cvt_pk_bf16(h0[2], h0[3]); w.z = cvt_pk_bf16(h1[0], h1[1]); w.w = cvt_pk_bf16(h1[2], h1[3]);
                const u32x4 wx = X(w); if (ai * 128 + wr * 64 + m * 16 + X.fr2 < u.aux) *(u32x4*)(HE + row * 256 + ct * 128 + wc * 32 + X.fq2 * 8) = wx; }
    }
};
struct EpiE2 {
    static constexpr bool PERM = true, MID = false;
    bf16* YE;
    __device__ __forceinline__ void operator()(AccRef acc, const Unit& u, int wr, int wc, int fr, int fq) const {
        const int ct = u.pn & 3; const EpiX X(fr, fq);
#pragma unroll
        for (int ai = 0; ai < 2; ++ai)
#pragma unroll
            for (int m = 0; m < 4; ++m) { const size_t row = (size_t)u.pm * 256 + ai * 128 + wr * 64 + m * 16 + X.fr2;
#pragma unroll
                for (int bj = 0; bj < 2; ++bj) { const f32x4 v0 = acc[ai][bj][m][0], v1 = acc[ai][bj][m][1];
                    u32x4 w; w.x = cvt_pk_bf16(v0[0], v0[1]); w.y = cvt_pk_bf16(v0[2], v0[3]); w.z = cvt_pk_bf16(v1[0], v1[1]); w.w = cvt_pk_bf16(v1[2], v1[3]);
                    const u32x4 wx = X(w); if (ai * 128 + wr * 64 + m * 16 + X.fr2 < u.aux) *(u32x4*)(YE + row * DM + ct * 256 + bj * 128 + wc * 32 + X.fq2 * 8) = wx; }
                asm volatile("" ::: "memory"); }
    }
};

struct Frame {
    LAS unsigned char* lds; int tid, lane, wave, vcu, G, gw, NGW; unsigned long long* tsw;
};
__device__ __forceinline__ float shx(float v, int mask, int lane) { return __builtin_bit_cast(float, __builtin_amdgcn_ds_bpermute((lane ^ mask) << 2, __builtin_bit_cast(int, v))); }
__device__ __forceinline__ int shxi(int v, int mask, int lane) { return __builtin_amdgcn_ds_bpermute((lane ^ mask) << 2, v); }
__device__ __forceinline__ float shf(float v, int src) { return __builtin_bit_cast(float, __builtin_amdgcn_ds_bpermute(src << 2, __builtin_bit_cast(int, v))); }
__device__ __forceinline__ float wave_sum(float v, int lane) {
#pragma unroll
    for (int o = 1; o < 64; o <<= 1) v += shx(v, o, lane);
    return v;
}
struct Map64Ident { __device__ int operator()(int n, int& ncv) const { ncv = 64; return n; } };
struct Map64AG { int half; __device__ int operator()(int n, int& ncv) const { ncv = 64; const int ct = n >> 8, x = n & 255; return (x < 128) ? ct * 128 + x : half + ct * 128 + (x - 128); } };
struct Map64Pad { int nsrc; __device__ int operator()(int n, int& ncv) const { ncv = (n < nsrc) ? 64 : 0; return n < nsrc ? n : 0; } };
struct Map64Win { __device__ int operator()(int n, int& ncv) const { ncv = 64;
        if (n < 2560) { const int hh = n >> 6; if (hh < 8) return hh * 64; if (hh < 16) { const int i = 2 + ((hh - 8) >> 1), g = hh & 1; return 512 + i * 128 + g * 64; } const int i = (hh - 16) >> 3, h = (hh - 16) & 7; return 1304 + i * 512 + h * 64; }
        if (n < 2816) return 512 + ((n - 2560) >> 6) * 64;
        if (n < 4352) return 2840 + (n - 2816);
        if (n < 7424) return 4376 + (n - 4352);
        if (n == 7424) { ncv = 24; return 1280; }
        ncv = 0; return 0; } };
template <class Map>
__device__ __forceinline__ void cvt_fast(Frame& F, const float* W, int lds_, int K, int Nd, bf16* WT, int pitch, const Map& cm, int nbatch, size_t sstride, size_t dstride, int gw, int ngw) {
    const int nkt = K / 64, nnt = Nd / 64, per = nkt * nnt, items = per * nbatch;
    const int n4 = F.lane & 15, kq = F.lane >> 4;
#define CVX_LOAD(R, it_) do { const int bi_ = (it_) / per, r_ = (it_) % per, kt_ = r_ / nnt, nt_ = r_ % nnt; int ncv_; const int c0_ = cm(nt_ * 64, ncv_); \
        if (n4 * 4 < ncv_) { const float* src_ = W + (size_t)bi_ * sstride + (size_t)(kt_ * 64 + kq * 16) * lds_ + c0_ + n4 * 4; _Pragma("unroll") for (int i_ = 0; i_ < 16; ++i_) R[i_] = *(const f32x4*)(src_ + (size_t)i_ * lds_); } \
        else { _Pragma("unroll") for (int i_ = 0; i_ < 16; ++i_) R[i_] = (f32x4){0.f, 0.f, 0.f, 0.f}; } } while (0)
#define CVX_STORE(R, it_) do { const int bi_ = (it_) / per, r_ = (it_) % per, kt_ = r_ / nnt, nt_ = r_ % nnt; \
          \
        _Pragma("unroll") for (int c_ = 0; c_ < 4; ++c_) _Pragma("unroll") for (int h_ = 0; h_ < 2; ++h_) { v4u o_; \
            o_.x = cvt_pk_bf16(R[8 * h_ + 0][c_], R[8 * h_ + 1][c_]); o_.y = cvt_pk_bf16(R[8 * h_ + 2][c_], R[8 * h_ + 3][c_]); o_.z = cvt_pk_bf16(R[8 * h_ + 4][c_], R[8 * h_ + 5][c_]); o_.w = cvt_pk_bf16(R[8 * h_ + 6][c_], R[8 * h_ + 7][c_]); \
            *(LAS v4u*)(stg + (n4 * 4 + c_) * 128 + (((2 * kq + h_) ^ (n4 & 7)) * 16)) = o_; } \
        bf16* dst_ = WT + (size_t)bi_ * dstride + (size_t)(nt_ * 64 + (F.lane >> 3)) * pitch + kt_ * 64 + (F.lane & 7) * 8; \
        _Pragma("unroll") for (int j_ = 0; j_ < 8; ++j_) { const int rr_ = j_ * 8 + (F.lane >> 3); \
            const v4u v_ = *(const LAS v4u*)(stg + rr_ * 128 + ((((F.lane & 7) ^ ((rr_ >> 2) & 7))) * 16)); *(v4u*)(dst_ + (size_t)(j_ * 8) * pitch) = v_; } } while (0)
    LAS char* const stg = (LAS char*)F.lds + F.wave * 8192;
    f32x4 ra[16], rb[16], rc[16];
    for (int it = gw; it < items; it += 3 * ngw) {
        const int itB = it + ngw, itC = it + 2 * ngw; const bool hasB = itB < items, hasC = itC < items;
        CVX_LOAD(ra, it);
        if (hasB) CVX_LOAD(rb, itB);
        if (hasC) CVX_LOAD(rc, itC);
        CVX_STORE(ra, it);
        if (hasB) CVX_STORE(rb, itB);
        if (hasC) CVX_STORE(rc, itC);
    }
#undef CVX_LOAD
#undef CVX_STORE
}

template <bool GATHER>
__device__ __forceinline__ void ln_phase(Frame& F, const bf16* res, const bf16* delta, const bf16* ye, const int* pos, const float* rwt, const float* gam, const float* bet, float* outf, bf16* outb, float oscale = 1.0f) {
    const int lane = F.lane;
    f32x4 gv[4], bv[4];
    if (!GATHER) {
#pragma unroll
        for (int j = 0; j < 4; ++j) { gv[j] = *((const f32x4*)gam + lane + 64 * j); bv[j] = *((const f32x4*)bet + lane + 64 * j); } }
    v2u rr[4]; v2u dd[4]; v2u yy[GATHER ? 8 : 1][4]; float ww[GATHER ? 8 : 1];
#define LN_REQ(row_) do { const size_t ro_ = (size_t)(row_) * DM; _Pragma("unroll") for (int j_ = 0; j_ < 4; ++j_) { rr[j_] = *((const v2u*)(res + ro_) + lane + 64 * j_); dd[j_] = *((const v2u*)(delta + ro_) + lane + 64 * j_); } \
        if (GATHER) { _Pragma("unroll") for (int k_ = 0; k_ < 8; ++k_) { const bf16* yr_ = ye + (size_t)pos[(size_t)(row_) * 8 + k_] * DM; ww[k_] = rwt[(size_t)(row_) * 8 + k_]; \
            _Pragma("unroll") for (int j_ = 0; j_ < 4; ++j_) yy[k_][j_] = *((const v2u*)yr_ + lane + 64 * j_); } } } while (0)
    const bool grp = (F.G == 256);
    int r = grp ? (F.vcu >> 5) * SEQ + (F.vcu & 31) * NWAVES + F.wave : F.gw;
    const int rstep = grp ? 32 * NWAVES : F.NGW, rend = grp ? ((F.vcu >> 5) + 1) * SEQ : T;
    if (r < rend) LN_REQ(r);
    for (; r < rend; r += rstep) {
        f32x4 v[4];
#pragma unroll
        for (int j = 0; j < 4; ++j) { const f32x4 d = (f32x4){bflo(dd[j].x), bfhi(dd[j].x), bflo(dd[j].y), bfhi(dd[j].y)}, rf = (f32x4){bflo(rr[j].x), bfhi(rr[j].x), bflo(rr[j].y), bfhi(rr[j].y)}; v[j] = rf * DN_ALPHA + d; }
        if (GATHER) {
#pragma unroll
            for (int k = 0; k < 8; ++k)
#pragma unroll
                for (int j = 0; j < 4; ++j) { v[j][0] += ww[k] * bflo(yy[k][j].x); v[j][1] += ww[k] * bfhi(yy[k][j].x); v[j][2] += ww[k] * bflo(yy[k][j].y); v[j][3] += ww[k] * bfhi(yy[k][j].y); } }
        if (r + rstep < rend) LN_REQ(r + rstep);
        float s = 0.f;
#pragma unroll
        for (int j = 0; j < 4; ++j) s += (v[j][0] + v[j][1]) + (v[j][2] + v[j][3]);
        const float mean = wave_sum(s, lane) * (1.f / DM); float s2 = 0.f;
#pragma unroll
        for (int j = 0; j < 4; ++j) { v[j] = v[j] - mean; s2 += (v[j][0] * v[j][0] + v[j][1] * v[j][1]) + (v[j][2] * v[j][2] + v[j][3] * v[j][3]); }
        const float rstd = 1.f / sqrtf(wave_sum(s2, lane) * (1.f / DM) + LN_EPS);
#pragma unroll
        for (int j = 0; j < 4; ++j) { if (GATHER) { gv[j] = *((const f32x4*)gam + lane + 64 * j); bv[j] = *((const f32x4*)bet + lane + 64 * j); } const f32x4 o = (v[j] * rstd * gv[j] + bv[j]) * oscale;
            if (outf) *((f32x4*)(outf + (size_t)r * DM) + lane + 64 * j) = o;
            if (outb) { v2u w; w.x = cvt_pk_bf16(o[0], o[1]); w.y = cvt_pk_bf16(o[2], o[3]); *((v2u*)(outb + (size_t)r * DM) + lane + 64 * j) = w; } }
    }
#undef LN_REQ
}

constexpr int AT_K = 0  , AT_V = 33792  , AT_WS = 66560, AT_OST = 68608  , AT_IMP = AT_OST  ,
              AT_MASK = LDSCTL_OFF + 1024, AT_TL = LDSCTL_OFF + 3072, AT_KM = LDSCTL_OFF + 4096;
__device__ __forceinline__ void lds_fadd(LAS float* p, float v) { (void)__hip_atomic_fetch_add(p, v, __ATOMIC_RELAXED, __HIP_MEMORY_SCOPE_WORKGROUP); }
__device__ __forceinline__ void lds_or(LAS unsigned* p, unsigned v) { (void)__hip_atomic_fetch_or(p, v, __ATOMIC_RELAXED, __HIP_MEMORY_SCOPE_WORKGROUP); }
__device__ __forceinline__ int opq(int v) { asm volatile("" : "+v"(v)); return v; }
__device__ __forceinline__ int crow(int r, int hi) { return (r & 3) + 8 * (r >> 2) + 4 * hi; }
__device__ __forceinline__ float pswap_max(float m) { auto rr = __builtin_amdgcn_permlane32_swap(__float_as_uint(m), __float_as_uint(m), false, false); return fmaxf(__uint_as_float(rr[0]), __uint_as_float(rr[1])); }
__device__ __forceinline__ float pswap_sum(float m) { auto rr = __builtin_amdgcn_permlane32_swap(__float_as_uint(m), __float_as_uint(m), false, false); return __uint_as_float(rr[0]) + __uint_as_float(rr[1]); }
__device__ __forceinline__ s16x4 vtr(const LAS char* p) { return __builtin_bit_cast(s16x4, __builtin_amdgcn_ds_read_tr16_b64_v4i16((LAS s16x4*)p)); }

template <int D> struct AttnSt {
    f32x16 o[D / 32]; f32x16 ls;
    float l;
    float m; bool fresh;
    v4u qb;
    bf16x8 qr[D / 16];
};
template <int D, bool WITH_V>
__device__ __forceinline__ void at_load(v4u (&kr)[D / 64], v4u (&vr)[D / 64], const bf16* Kg, const bf16* Vg, int pitch, int kv0, int wid, int lane) {
#pragma unroll
    for (int i = 0; i < D / 64; ++i) { const int pi = wid + 8 * i;
        kr[i] = *(const v4u*)(Kg + (size_t)(kv0 + (8 * i + wid) * (512 / D) + lane / (D / 8)) * pitch + (lane % (D / 8)) * 8);
        if (WITH_V) { const int dblk = pi >> 2, rg = pi & 3; vr[i] = *(const v4u*)(Vg + (size_t)(kv0 + 16 * rg + (lane >> 2)) * pitch + dblk * 32 + (lane & 3) * 8); } }
}
__device__ __forceinline__ void at_vdma64(const bf16* Vg, int pitch, int kv0, LAS char* Vs, int wid, int lane) {
    const int dblk = wid >> 2, rg = wid & 3;
    __builtin_amdgcn_global_load_lds((const unsigned*)(Vg + (size_t)(kv0 + 16 * rg + (lane >> 2)) * pitch + dblk * 32 + (lane & 3) * 8), (LAS unsigned*)(Vs + wid * 1024), 16, 0, 0);
}
__device__ __forceinline__ void at_kdma64(const bf16* Kg, int pitch, int kv0, LAS char* Ks, int wid, int lane) {
    __builtin_amdgcn_global_load_lds((const unsigned*)(Kg + (size_t)(kv0 + lane) * pitch + wid * 8), (LAS unsigned*)(Ks + wid * 1040), 16, 0, 0);
}
template <int D, bool WITH_V>
__device__ __forceinline__ void at_store(const v4u (&kr)[D / 64], const v4u (&vr)[D / 64], LAS char* Ks, LAS char* Vs, int wid, int lane) {
#pragma unroll
    for (int i = 0; i < D / 64; ++i) { const int pi = wid + 8 * i;
        *(LAS v4u*)(Ks + (lane % (D / 8)) * 1040 + ((8 * i + wid) * (512 / D) + lane / (D / 8)) * 16) = kr[i];
        if (WITH_V) *(LAS v4u*)(Vs + pi * 1024 + lane * 16) = vr[i]; }
}
template <int D, bool INIT = false>
__device__ __forceinline__ void at_qk(f32x16& p0, f32x16& p1, const LAS char* Ks, const bf16x8 (&qr)[D / 16], int r32, int hi) {
    const LAS char* kb = Ks + hi * 1040 + r32 * 16;
    if (!INIT) { p0 = f32x16{}; p1 = f32x16{}; }
    bf16x8 ka = *(const LAS bf16x8*)(kb), kc = *(const LAS bf16x8*)(kb + 512);
#pragma unroll
    for (int d0 = 0; d0 < D / 16; ++d0) {
        bf16x8 na = ka, nc = kc;
        if (d0 + 1 < D / 16) { na = *(const LAS bf16x8*)(kb + (d0 + 1) * 2080); nc = *(const LAS bf16x8*)(kb + (d0 + 1) * 2080 + 512); }
        p0 = __builtin_amdgcn_mfma_f32_32x32x16_bf16(ka, qr[d0], p0, 0, 0, 0);
        p1 = __builtin_amdgcn_mfma_f32_32x32x16_bf16(kc, qr[d0], p1, 0, 0, 0);
        __builtin_amdgcn_sched_barrier(0);
        ka = na; kc = nc;
    }
}
template <int D>
__device__ __forceinline__ void at_pv(f32x16 (&o)[D / 32], const f32x16& p0, const f32x16& p1, const LAS char* Vs, int lane, int hi, bool rowmask = false, bool keep = true, f32x16* ls = nullptr) {
    bf16x8 pa[4];
#pragma unroll
    for (int ks = 0; ks < 4; ++ks) { const f32x16& P = (ks < 2) ? p0 : p1; const int b = (ks & 1) * 8;
        v4u w; w.x = cvt_pk_bf16(P[b + 0], P[b + 1]); w.y = cvt_pk_bf16(P[b + 2], P[b + 3]); w.z = cvt_pk_bf16(P[b + 4], P[b + 5]); w.w = cvt_pk_bf16(P[b + 6], P[b + 7]);
        if (rowmask) { w.x = keep ? w.x : 0u; w.y = keep ? w.y : 0u; w.z = keep ? w.z : 0u; w.w = keep ? w.w : 0u; }
        pa[ks] = __builtin_bit_cast(bf16x8, w); }
    const LAS char* vp = Vs + ((lane >> 4) & 1) * 32 + (lane & 3) * 8 + (4 * hi + ((lane & 15) >> 2)) * 64;
    if (ls) { const v4u one4 = (v4u){0x3F803F80u, 0x3F803F80u, 0x3F803F80u, 0x3F803F80u}; const bf16x8 ones = __builtin_bit_cast(bf16x8, one4);
#pragma unroll
        for (int ks = 0; ks < 4; ++ks) *ls = __builtin_amdgcn_mfma_f32_32x32x16_bf16(pa[ks], ones, *ls, 0, 0, 0); }
    constexpr int ND = D / 32;
    s16x4 lo[ND], hh[ND];
#pragma unroll
    for (int dd = 0; dd < ND; ++dd) { lo[dd] = vtr(vp + dd * 4096); hh[dd] = vtr(vp + dd * 4096 + 512); }
#pragma unroll
    for (int ks = 0; ks < 4; ++ks) {
        s16x4 nlo[ND], nhh[ND];
#pragma unroll
        for (int dd = 0; dd < ND; ++dd) { nlo[dd] = lo[dd]; nhh[dd] = hh[dd]; if (ks + 1 < 4) { nlo[dd] = vtr(vp + dd * 4096 + (ks + 1) * 1024); nhh[dd] = vtr(vp + dd * 4096 + (ks + 1) * 1024 + 512); } }
#pragma unroll
        for (int dd = 0; dd < ND; ++dd) { const bf16x8 vb = (bf16x8){lo[dd][0], lo[dd][1], lo[dd][2], lo[dd][3], hh[dd][0], hh[dd][1], hh[dd][2], hh[dd][3]};
            o[dd] = __builtin_amdgcn_mfma_f32_32x32x16_bf16(pa[ks], vb, o[dd], 0, 0, 0); }
        __builtin_amdgcn_sched_barrier(0);
#pragma unroll
        for (int dd = 0; dd < ND; ++dd) { lo[dd] = nlo[dd]; hh[dd] = nhh[dd]; }
    }
}
__device__ __forceinline__ float max3f(float a, float b, float c) { return __builtin_fmaxf(__builtin_fmaxf(a, b), c); }
__device__ __forceinline__ float max32(const f32x16& p0, const f32x16& p1) {
    float a = max3f(p0[0], p0[1], p1[0]), b = max3f(p0[2], p0[3], p1[1]);
    a = max3f(a, p1[2], p1[3]);
#pragma unroll
    for (int r = 4; r < 16; r += 4) { a = max3f(a, p0[r], p0[r + 1]); b = max3f(b, p0[r + 2], p0[r + 3]); a = max3f(a, p1[r], p1[r + 1]); b = max3f(b, p1[r + 2], p1[r + 3]); }
    return __builtin_fmaxf(a, b);
}
template <int ND>
__device__ __forceinline__ void at_scale_rows(f32x16 (&o)[ND], f32x16& ls, float f, LAS float* wsf, int r32, int hi) {
    if (hi == 0) wsf[r32] = f;
    LDS_WAIT();
#pragma unroll
    for (int g = 0; g < 4; ++g) { const f32x4 fv = *(const LAS f32x4*)(wsf + 8 * g + 4 * hi);
#pragma unroll
        for (int d = 0; d < ND; ++d) { o[d][4 * g + 0] *= fv[0]; o[d][4 * g + 1] *= fv[1]; o[d][4 * g + 2] *= fv[2]; o[d][4 * g + 3] *= fv[3]; }
        ls[4 * g + 0] *= fv[0]; ls[4 * g + 1] *= fv[1]; ls[4 * g + 2] *= fv[2]; ls[4 * g + 3] *= fv[3]; }
    LDS_WAIT();
}
template <int ND>
__device__ __forceinline__ void at_normalize(f32x16 (&o)[ND], const f32x16& ls) {
#pragma unroll
    for (int r = 0; r < 16; ++r) { const float inv = __builtin_amdgcn_rcpf(ls[r]);
#pragma unroll
        for (int d = 0; d < ND; ++d) o[d][r] *= inv; }
}
constexpr float AT_THR = 4.0f;
constexpr int AT_SKEW = 0;
__device__ __forceinline__ void at_set_negm(v4u& qb, float m, int hi) {
    const float nm = -m; const float m1 = __uint_as_float(__float_as_uint(nm) & 0xffff0000u), r1 = nm - m1, m2 = __uint_as_float(__float_as_uint(r1) & 0xffff0000u), r2 = r1 - m2, m3 = __uint_as_float(__float_as_uint(r2) & 0xffff0000u);
    const unsigned w0 = (__float_as_uint(m1) >> 16) | (__float_as_uint(m2) & 0xffff0000u), w1 = __float_as_uint(m3) >> 16;
    qb.x = hi ? w0 : qb.x; qb.y = hi ? w1 : qb.y;
}
template <int D>
__device__ __forceinline__ void at_std_tile(AttnSt<D>& st, f32x16& p0, f32x16& p1, const LAS char* Vs, int lim_hi, int lim_lo, int mask_mode, bool rowact,
                                            LAS float* wsf, int lane, int r32, int hi) {
    if (mask_mode == 2) {
#pragma unroll
        for (int r = 0; r < 16; ++r) { const int pl = (r & 3) + 8 * (r >> 2) + 4 * hi;
            p0[r] = (pl <= lim_hi && pl >= lim_lo) ? p0[r] : -INFINITY; p1[r] = (pl + 32 <= lim_hi && pl + 32 >= lim_lo) ? p1[r] : -INFINITY; }
    }
    float rm = pswap_max(max32(p0, p1));
    if (mask_mode == 1) rm = rowact ? rm : -INFINITY;
    const bool need = st.fresh ? (rm > -INFINITY) : (rm > AT_THR);
    if (__any(need)) {
        const float dl = need ? rm : 0.f;
        const float al = (need && !st.fresh) ? __builtin_amdgcn_exp2f(-dl) : 1.0f;
#pragma unroll
        for (int r = 0; r < 16; ++r) { p0[r] -= dl; p1[r] -= dl; }
        st.m += dl; st.fresh = st.fresh && !need;
        at_set_negm(st.qb, st.m, hi); st.l *= al;
        at_scale_rows<D / 32>(st.o, st.ls, al, wsf, r32, hi);
    }
#pragma unroll
    for (int r = 0; r < 16; ++r) { p0[r] = __builtin_amdgcn_exp2f(p0[r]); p1[r] = __builtin_amdgcn_exp2f(p1[r]); }
    if constexpr (D == 64) at_pv<D>(st.o, p0, p1, Vs, lane, hi, mask_mode == 1, rowact, &st.ls);
    else { float sum = 0.f;
#pragma unroll
        for (int r = 0; r < 16; ++r) { sum += p0[r]; sum += p1[r]; }
        if (mask_mode == 1) sum = rowact ? sum : 0.f;
        st.l += sum;
        at_pv<D>(st.o, p0, p1, Vs, lane, hi, mask_mode == 1, rowact, nullptr); }
}
template <int D, bool ALIBI = true>
__device__ __forceinline__ void at_std_pass1(AttnSt<D>& st, LAS unsigned char* lds, const bf16* Kg, const bf16* Vg, int pitch, const LAS int* tl, int ntile,
                                            int t, unsigned long long bits, int W, float sl2, int wid, int lane) {
    lane = opq(lane); const int r32 = lane & 31, hi = lane >> 5;
    const unsigned almask = hi ? 0u : 0xffffu;
    const unsigned alb0 = hi ? 0u : ((__float_as_uint((float)r32) >> 16) << 16), alb1 = hi ? 0u : ((__float_as_uint((float)(r32 + 32)) >> 16) << 16);
    { const float s1f = __uint_as_float(__float_as_uint(sl2) & 0xffff0000u), r1 = sl2 - s1f, s2f = __uint_as_float(__float_as_uint(r1) & 0xffff0000u), r2 = r1 - s2f, s3f = __uint_as_float(__float_as_uint(r2) & 0xffff0000u);
      const unsigned b1 = __float_as_uint(s1f) >> 16, b2 = __float_as_uint(s2f) >> 16, b3 = __float_as_uint(s3f) >> 16;
      st.qb.x = hi ? 0u : (b1 | (b2 << 16)); st.qb.y = hi ? 0u : (b3 | (b1 << 16)); st.qb.z = hi ? 0u : (b2 | (b3 << 16)); st.qb.w = 0u; }
    LAS float* wsf = (LAS float*)(lds + AT_WS) + wid * 64;
    constexpr int SLOT = 64 * D * 2, KSLOT = 130 * D;
    v4u kr[D / 64], vr[D / 64];
#pragma unroll
    for (int d = 0; d < D / 32; ++d) st.o[d] = f32x16{};
    st.ls = f32x16{}; st.l = 0.f; st.m = 0.f; st.fresh = true;
    if (ntile <= 0) return;
    at_load<D, true>(kr, vr, Kg, Vg, pitch, __builtin_amdgcn_readfirstlane(tl[0]) * 64, wid, lane);
    at_store<D, true>(kr, vr, (LAS char*)lds + AT_K, (LAS char*)lds + AT_V, wid, lane);
    __syncthreads();
    for (int it = 0; it < ntile; ++it) {
        const int cur = it & 1; const int kt = __builtin_amdgcn_readfirstlane(tl[it]);
        if (it + 1 < ntile) at_load<D, true>(kr, vr, Kg, Vg, pitch, __builtin_amdgcn_readfirstlane(tl[it + 1]) * 64, wid, lane);
        const LAS char* Ks = (const LAS char*)lds + AT_K + cur * KSLOT; const LAS char* Vs = (const LAS char*)lds + AT_V + cur * SLOT;
        const int kvbase = kt * 64;
        const bool rowok = (bits >> kt) & 1ull;
        const int lim_hi = rowok ? (t - kvbase) : -1, lim_lo = t - W + 1 - kvbase;
        const bool active = (lim_hi >= 0) && (lim_lo <= 63) && (lim_lo <= lim_hi);
        if (__any(active)) {
            const bool full = (lim_hi >= 63 && lim_lo <= 0);
            const int mask_mode = __any(active && !full) ? 2 : (__any(!active) ? 1 : 0);
            f32x16 p0, p1;
            {
                const unsigned a16 = ALIBI ? (unsigned)__builtin_amdgcn_readfirstlane((int)(__float_as_uint((float)kvbase) >> 16)) : 0u;
                v4u ka; ka.x = hi ? 0x3F803F80u : (a16 * 0x10001u); ka.y = hi ? 0x3F80u : ((a16 & almask) | alb0); ka.z = alb0 | (alb0 >> 16); ka.w = 0u;
                v4u kb2 = ka; kb2.y = hi ? 0x3F80u : ((a16 & almask) | alb1); kb2.z = alb1 | (alb1 >> 16);
                const bf16x8 qbv = __builtin_bit_cast(bf16x8, st.qb);
                at_qk<D, false>(p0, p1, Ks, st.qr, r32, hi);
                p0 = __builtin_amdgcn_mfma_f32_32x32x16_bf16(__builtin_bit_cast(bf16x8, ka), qbv, p0, 0, 0, 0);
                p1 = __builtin_amdgcn_mfma_f32_32x32x16_bf16(__builtin_bit_cast(bf16x8, kb2), qbv, p1, 0, 0, 0);
            }
            at_std_tile<D>(st, p0, p1, Vs, lim_hi, lim_lo, mask_mode, active, wsf, lane, r32, hi);
        }
        if (it + 1 < ntile) at_store<D, true>(kr, vr, (LAS char*)lds + AT_K + (cur ^ 1) * KSLOT, (LAS char*)lds + AT_V + (cur ^ 1) * SLOT, wid, lane);
        __syncthreads();
    }
}
constexpr int AT_V8 = 8 * 8320, AT_WS8 = AT_V8 + 8 * 8192;
static_assert(AT_WS8 + 2048 <= LDSCTL_OFF, "8-slot rings overflow the phase scratch");
template <int D, bool ALIBI = true, bool RING8 = false>
__device__ __forceinline__ void at_std_pass(AttnSt<D>& st, LAS unsigned char* lds, const bf16* Kg, const bf16* Vg, int pitch, const LAS int* tl, int ntile,
                                            int t, unsigned long long bits, int W, float sl2, int wid, int lane) {
    lane = opq(lane); const int r32 = lane & 31, hi = lane >> 5;
    const unsigned almask = hi ? 0u : 0xffffu;
    const unsigned alb0 = hi ? 0u : ((__float_as_uint((float)r32) >> 16) << 16), alb1 = hi ? 0u : ((__float_as_uint((float)(r32 + 32)) >> 16) << 16);
    { const float s1f = __uint_as_float(__float_as_uint(sl2) & 0xffff0000u), r1 = sl2 - s1f, s2f = __uint_as_float(__float_as_uint(r1) & 0xffff0000u), r2 = r1 - s2f, s3f = __uint_as_float(__float_as_uint(r2) & 0xffff0000u);
      const unsigned b1 = __float_as_uint(s1f) >> 16, b2 = __float_as_uint(s2f) >> 16, b3 = __float_as_uint(s3f) >> 16;
      st.qb.x = hi ? 0u : (b1 | (b2 << 16)); st.qb.y = hi ? 0u : (b3 | (b1 << 16)); st.qb.z = hi ? 0u : (b2 | (b3 << 16)); st.qb.w = 0u; }
    LAS float* wsf = (LAS float*)(lds + (RING8 ? AT_WS8 : AT_WS)) + wid * 64;
    constexpr int SLOT = 64 * D * 2, KSLOT = 130 * D;
    v4u kr[D / 64], vr[D / 64];
#pragma unroll
    for (int d = 0; d < D / 32; ++d) st.o[d] = f32x16{};
    st.ls = f32x16{}; st.l = 0.f; st.m = 0.f; st.fresh = true;
    if (ntile <= 0) return;
#define TSQ() do {} while (0)
#define AT_TILE(kt_, Ks_, Vs_) do { const int kvbase = (kt_) * 64; const bool rowok = (bits >> (kt_)) & 1ull; \
        const int lim_hi = rowok ? (t - kvbase) : -1, lim_lo = t - W + 1 - kvbase; const bool active = (lim_hi >= 0) && (lim_lo <= 63) && (lim_lo <= lim_hi); \
        if (__any(active)) { const bool full = (lim_hi >= 63 && lim_lo <= 0); const int mask_mode = __any(active && !full) ? 2 : (__any(!active) ? 1 : 0); \
            f32x16 p0, p1; \
            const unsigned a16 = ALIBI ? (unsigned)__builtin_amdgcn_readfirstlane((int)(__float_as_uint((float)kvbase) >> 16)) : 0u; \
            v4u ka; ka.x = hi ? 0x3F803F80u : (a16 * 0x10001u); ka.y = hi ? 0x3F80u : ((a16 & almask) | alb0); ka.z = alb0 | (alb0 >> 16); ka.w = 0u; \
            v4u kb2 = ka; kb2.y = hi ? 0x3F80u : ((a16 & almask) | alb1); kb2.z = alb1 | (alb1 >> 16); \
            const bf16x8 qbv = __builtin_bit_cast(bf16x8, st.qb); \
            TSQ(); \
            at_qk<D, false>(p0, p1, (Ks_), st.qr, r32, hi); \
            p0 = __builtin_amdgcn_mfma_f32_32x32x16_bf16(__builtin_bit_cast(bf16x8, ka), qbv, p0, 0, 0, 0); \
            p1 = __builtin_amdgcn_mfma_f32_32x32x16_bf16(__builtin_bit_cast(bf16x8, kb2), qbv, p1, 0, 0, 0); \
            at_std_tile<D>(st, p0, p1, (Vs_), lim_hi, lim_lo, mask_mode, active, wsf, lane, r32, hi); } } while (0)
    if constexpr (RING8) {
        static_assert(D == 64, "RING8 is the D = 64 layout");
        v4u kr2[1], vr2[1];
        const int npair = (ntile + 1) >> 1;
#define TLX(i_) (((i_) < ntile) ? __builtin_amdgcn_readfirstlane(tl[(i_)]) : 0)
        int c0 = TLX(0), c1 = TLX(1), d0 = TLX(2), d1 = TLX(3), e0 = TLX(4), e1 = TLX(5);
        at_kdma64(Kg, pitch, c0 * 64, (LAS char*)lds + AT_K, wid, lane); at_vdma64(Vg, pitch, c0 * 64, (LAS char*)lds + AT_V8, wid, lane);
        if (ntile > 1) { at_kdma64(Kg, pitch, c1 * 64, (LAS char*)lds + AT_K + KSLOT, wid, lane); at_vdma64(Vg, pitch, c1 * 64, (LAS char*)lds + AT_V8 + SLOT, wid, lane); }
        if (ntile > 2) { at_kdma64(Kg, pitch, d0 * 64, (LAS char*)lds + AT_K + 2 * KSLOT, wid, lane); at_vdma64(Vg, pitch, d0 * 64, (LAS char*)lds + AT_V8 + 2 * SLOT, wid, lane);
            if (ntile > 3) { at_kdma64(Kg, pitch, d1 * 64, (LAS char*)lds + AT_K + 3 * KSLOT, wid, lane); at_vdma64(Vg, pitch, d1 * 64, (LAS char*)lds + AT_V8 + 3 * SLOT, wid, lane); } }
        __syncthreads();
        for (int p = 0; p < npair; ++p) {
            const int s0 = (p & 3) * 2, s2 = ((p + 2) & 3) * 2; const int i0 = 2 * p, i1 = 2 * p + 1;
            const bool n0 = (i0 + 4 < ntile), n1 = (i1 + 4 < ntile);
            if (n0) { at_kdma64(Kg, pitch, e0 * 64, (LAS char*)lds + AT_K + s2 * KSLOT, wid, lane); at_vdma64(Vg, pitch, e0 * 64, (LAS char*)lds + AT_V8 + s2 * SLOT, wid, lane); }
            if (n1) { at_kdma64(Kg, pitch, e1 * 64, (LAS char*)lds + AT_K + (s2 + 1) * KSLOT, wid, lane); at_vdma64(Vg, pitch, e1 * 64, (LAS char*)lds + AT_V8 + (s2 + 1) * SLOT, wid, lane); }
            const int q0 = (i0 + 6 < ntile) ? tl[i0 + 6] : 0, q1 = (i1 + 6 < ntile) ? tl[i1 + 6] : 0;
            AT_TILE(c0, (const LAS char*)lds + AT_K + s0 * KSLOT, (const LAS char*)lds + AT_V8 + s0 * SLOT);
            __builtin_amdgcn_sched_barrier(0);
            if (i1 < ntile) AT_TILE(c1, (const LAS char*)lds + AT_K + (s0 + 1) * KSLOT, (const LAS char*)lds + AT_V8 + (s0 + 1) * SLOT);
            __builtin_amdgcn_sched_barrier(0);
            c0 = d0; c1 = d1; d0 = e0; d1 = e1; e0 = __builtin_amdgcn_readfirstlane(q0); e1 = __builtin_amdgcn_readfirstlane(q1);
            if ((p & 1) || p + 1 == npair) __syncthreads();
        }
#undef TLX
    } else if constexpr (D == 64) {
        v4u kr2[1], vr2[1];
        const int npair = (ntile + 1) >> 1;
        { const int t0_ = __builtin_amdgcn_readfirstlane(tl[0]) * 64; at_kdma64(Kg, pitch, t0_, (LAS char*)lds + AT_K, wid, lane); at_vdma64(Vg, pitch, t0_, (LAS char*)lds + AT_V, wid, lane); }
        if (ntile > 1) { const int t1_ = __builtin_amdgcn_readfirstlane(tl[1]) * 64; at_kdma64(Kg, pitch, t1_, (LAS char*)lds + AT_K + KSLOT, wid, lane); at_vdma64(Vg, pitch, t1_, (LAS char*)lds + AT_V + SLOT, wid, lane); }
        __syncthreads();
#define TS(x) do {} while (0)
        int kt0 = __builtin_amdgcn_readfirstlane(tl[0]), kt1 = (ntile > 1) ? __builtin_amdgcn_readfirstlane(tl[1]) : 0;
        int nk0 = (ntile > 2) ? __builtin_amdgcn_readfirstlane(tl[2]) : 0, nk1 = (ntile > 3) ? __builtin_amdgcn_readfirstlane(tl[3]) : 0;
        for (int p = 0; p < npair; ++p) {
            TS(tA);
            const int s0 = (p & 1) * 2; const int i0 = 2 * p, i1 = 2 * p + 1;
            const bool n0 = (i0 + 2 < ntile), n1 = (i1 + 2 < ntile);
            if (n0) { at_kdma64(Kg, pitch, nk0 * 64, (LAS char*)lds + AT_K + (s0 ^ 2) * KSLOT, wid, lane); at_vdma64(Vg, pitch, nk0 * 64, (LAS char*)lds + AT_V + (s0 ^ 2) * SLOT, wid, lane); }
            if (n1) { at_kdma64(Kg, pitch, nk1 * 64, (LAS char*)lds + AT_K + ((s0 ^ 2) + 1) * KSLOT, wid, lane); at_vdma64(Vg, pitch, nk1 * 64, (LAS char*)lds + AT_V + ((s0 ^ 2) + 1) * SLOT, wid, lane); }
            const int q0 = (i0 + 4 < ntile) ? tl[i0 + 4] : 0, q1 = (i1 + 4 < ntile) ? tl[i1 + 4] : 0;
            if (AT_SKEW > 0 && wid >= 4) __builtin_amdgcn_s_sleep(AT_SKEW);
            TS(tB);
            AT_TILE(kt0, (const LAS char*)lds + AT_K + s0 * KSLOT, (const LAS char*)lds + AT_V + s0 * SLOT);
            __builtin_amdgcn_sched_barrier(0);
            if (i1 < ntile) AT_TILE(kt1, (const LAS char*)lds + AT_K + (s0 + 1) * KSLOT, (const LAS char*)lds + AT_V + (s0 + 1) * SLOT);
            __builtin_amdgcn_sched_barrier(0);
            TS(tC);
            const int s1 = s0 ^ 2;
            kt0 = nk0; kt1 = nk1; nk0 = __builtin_amdgcn_readfirstlane(q0); nk1 = __builtin_amdgcn_readfirstlane(q1);
            TS(tD);
            __syncthreads();
            TS(tE);
        }
    } else {
        at_load<D, true>(kr, vr, Kg, Vg, pitch, __builtin_amdgcn_readfirstlane(tl[0]) * 64, wid, lane);
        at_store<D, true>(kr, vr, (LAS char*)lds + AT_K, (LAS char*)lds + AT_V, wid, lane);
        __syncthreads();
        for (int it = 0; it < ntile; ++it) {
            const int cur = it & 1; const int kt = __builtin_amdgcn_readfirstlane(tl[it]);
            if (it + 1 < ntile) at_load<D, true>(kr, vr, Kg, Vg, pitch, __builtin_amdgcn_readfirstlane(tl[it + 1]) * 64, wid, lane);
            AT_TILE(kt, (const LAS char*)lds + AT_K + cur * KSLOT, (const LAS char*)lds + AT_V + cur * SLOT);
            if (it + 1 < ntile) at_store<D, true>(kr, vr, (LAS char*)lds + AT_K + (cur ^ 1) * KSLOT, (LAS char*)lds + AT_V + (cur ^ 1) * SLOT, wid, lane);
            __syncthreads();
        }
    }
#undef AT_TILE
}
__device__ __forceinline__ void at_pass_resident128(AttnSt<128>& st, LAS unsigned char* lds, const bf16* Kg, const bf16* Vg, int pitch, int nt, int wid, int lane) {
    lane = opq(lane); const int r32 = lane & 31, hi = lane >> 5;
    st.qb = (v4u){0u, 0u, 0u, 0u};
    LAS float* wsf = (LAS float*)(lds + AT_WS8) + wid * 64;
#pragma unroll
    for (int d = 0; d < 4; ++d) st.o[d] = f32x16{};
    st.ls = f32x16{}; st.l = 0.f; st.m = 0.f; st.fresh = true;
    for (int kt = 0; kt < nt; ++kt) {
#pragma unroll
        for (int i = 0; i < 2; ++i) { const int pi = wid + 8 * i;
            __builtin_amdgcn_global_load_lds((const unsigned*)(Kg + (size_t)(kt * 64 + lane) * pitch + pi * 8), (LAS unsigned*)((LAS char*)lds + AT_K + kt * 16640 + pi * 1040), 16, 0, 0);
            const int dblk = pi >> 2, rg = pi & 3;
            __builtin_amdgcn_global_load_lds((const unsigned*)(Vg + (size_t)(kt * 64 + 16 * rg + (lane >> 2)) * pitch + dblk * 32 + (lane & 3) * 8), (LAS unsigned*)((LAS char*)lds + AT_V8 + kt * 16384 + pi * 1024), 16, 0, 0); }
    }
    __syncthreads();
    for (int kt = 0; kt < nt; ++kt) {
        f32x16 p0, p1;
        {
            v4u ka; ka.x = hi ? 0x3F803F80u : 0u; ka.y = hi ? 0x3F80u : 0u; ka.z = 0u; ka.w = 0u;
            const bf16x8 qbv = __builtin_bit_cast(bf16x8, st.qb);
            at_qk<128, false>(p0, p1, (const LAS char*)lds + AT_K + kt * 16640, st.qr, r32, hi);
            p0 = __builtin_amdgcn_mfma_f32_32x32x16_bf16(__builtin_bit_cast(bf16x8, ka), qbv, p0, 0, 0, 0);
            p1 = __builtin_amdgcn_mfma_f32_32x32x16_bf16(__builtin_bit_cast(bf16x8, ka), qbv, p1, 0, 0, 0);
        }
        at_std_tile<128>(st, p0, p1, (const LAS char*)lds + AT_V8 + kt * 16384, 1 << 20, -(1 << 20), 0, true, wsf, lane, r32, hi);
    }
    __syncthreads();
}
template <int D, class RowPtr>
__device__ __forceinline__ void at_write(const f32x16 (&o)[D / 32], LAS unsigned char* lds, int wid, int lane, const RowPtr& rp) {
    lane = opq(lane); const int r32 = lane & 31, hi = lane >> 5;
    LAS bf16* stg = (LAS bf16*)(lds + AT_OST) + wid * (32 * D);
#pragma unroll
    for (int r = 0; r < 16; ++r) { const int orow = crow(r, hi);
#pragma unroll
        for (int d0 = 0; d0 < D / 32; ++d0) stg[orow * D + d0 * 32 + r32] = (bf16)f2bf(o[d0][r]); }
    LDS_WAIT();
    constexpr int CPR = D / 8;
    constexpr int RPI = 64 / CPR;
#pragma unroll
    for (int i = 0; i < 32 / RPI; ++i) { const int row = i * RPI + lane / CPR, ch = lane % CPR; const v4u v = *(const LAS v4u*)(stg + row * D + ch * 8); *(v4u*)(rp(row) + ch * 8) = v; }
    LDS_WAIT();
}

__device__ __forceinline__ void at_accum_lds(const f32x16 (&o)[2], const f32x16* ls, float f, bool first, LAS float* accb, LAS float* wsf, int r32, int hi) {
    if (hi == 0) wsf[r32] = f;
    LDS_WAIT();
#pragma unroll
    for (int g = 0; g < 4; ++g) { const f32x4 fv = *(const LAS f32x4*)(wsf + 8 * g + 4 * hi);
#pragma unroll
        for (int i = 0; i < 4; ++i) { const float fac = ls ? fv[i] * __builtin_amdgcn_rcpf((*ls)[4 * g + i]) : fv[i];
#pragma unroll
            for (int d = 0; d < 2; ++d) { LAS float* p = accb + (8 * g + 4 * hi + i) * 64 + d * 32 + r32; const float v = o[d][4 * g + i] * fac; *p = first ? v : (*p + v); } } }
    LDS_WAIT();
}
struct NsaRow { bf16* base; int pitch; __device__ bf16* operator()(int row) const { return base + (size_t)row * pitch; } };
__device__ __forceinline__ void nsa_unit(Frame& F, int b, int g, int tb, const bf16* HM, const bf16* CKV, const float* NG, bf16* YA) {
    LAS unsigned char* lds = F.lds; const int tid = (F.wave << 6) | lane_now(); const int wid = F.wave, lane = tid & 63, r32 = lane & 31, hi = lane >> 5;
    const int hd = wid >> 1, head = g * 4 + hd, tokl = (wid & 1) * 32 + r32, t = tb * 64 + tokl;
    LAS float* wsf = (LAS float*)(lds + AT_WS) + wid * 64;
    LAS float* imp = (LAS float*)(lds + AT_IMP);
    LAS unsigned* msk = (LAS unsigned*)(lds + AT_MASK);
    LAS int* tl = (LAS int*)(lds + AT_TL);
    AttnSt<64> st;
    { const bf16* qp = HM + ((size_t)(b * NHM + head) * SEQ + t) * 64;
#pragma unroll
      for (int d0 = 0; d0 < 4; ++d0) st.qr[d0] = *(const bf16x8*)(qp + d0 * 16 + hi * 8); }
    const float* ngp = NG + ((size_t)b * SEQ + t) * 24 + head * 3;
    const float g0 = ngp[0], g1 = ngp[1], g2 = ngp[2];
    LAS float* accb = (LAS float*)(lds + AT_OST) + wid * 2048;
    for (int i = tid; i < 64 * 65; i += 512) imp[i] = 0.f;
    if (tid < 130) msk[tid] = 0u;
    const bf16* Kc = CKV + (size_t)(b * 4 + 0 + g) * 256 * 64; const bf16* Vc = CKV + (size_t)(b * 4 + 2 + g) * 256 * 64;
    const int cmax = (t >= 31) ? ((t - 31) >> 4) : -1;
    const int ntc = (((tb * 64 + 63 - 31) >> 4) >> 6) + 1;
    float m = -1e30f, l = 0.f;
    __syncthreads();
    for (int kt = 0; kt < ntc; ++kt) { at_kdma64(Kc, 64, kt * 64, (LAS char*)lds + AT_K + kt * 8320, wid, lane); at_vdma64(Vc, 64, kt * 64, (LAS char*)lds + AT_V + kt * 8192, wid, lane); }
    __syncthreads();
    for (int kt = 0; kt < ntc; ++kt) {
        f32x16 p0, p1; at_qk<64>(p0, p1, (const LAS char*)lds + AT_K + kt * 8320, st.qr, r32, hi);
        const int lim = cmax - kt * 64;
#pragma unroll
        for (int r = 0; r < 16; ++r) { const int pl = crow(r, hi); p0[r] = (pl <= lim) ? p0[r] : -INFINITY; p1[r] = (pl + 32 <= lim) ? p1[r] : -INFINITY; }
        const float rm = pswap_max(max32(p0, p1));
        const float mn = fmaxf(m, rm);
        float sum = 0.f;
#pragma unroll
        for (int r = 0; r < 16; ++r) sum += __builtin_amdgcn_exp2f(p0[r] - mn) + __builtin_amdgcn_exp2f(p1[r] - mn);
        l = l * __builtin_amdgcn_exp2f(m - mn) + sum; m = mn;
    }
    l = pswap_sum(l);
    const float linv = (l > 0.f) ? 1.0f / l : 0.f;
    st.o[0] = f32x16{}; st.o[1] = f32x16{};
    for (int kt = 0; kt < ntc; ++kt) {
        f32x16 p0, p1; at_qk<64>(p0, p1, (const LAS char*)lds + AT_K + kt * 8320, st.qr, r32, hi);
        const int lim = cmax - kt * 64;
#pragma unroll
        for (int r = 0; r < 16; ++r) { const int pl = crow(r, hi);
            p0[r] = (pl <= lim) ? __builtin_amdgcn_exp2f(p0[r] - m) * linv : 0.f; p1[r] = (pl + 32 <= lim) ? __builtin_amdgcn_exp2f(p1[r] - m) * linv : 0.f; }
        LAS float* ir = imp + tokl * 65;
#pragma unroll
        for (int q = 0; q < 4; ++q) {
            { const int j = 16 * kt + 2 * q + hi; const float a = (p0[4 * q] + p0[4 * q + 1]) + (p0[4 * q + 2] + p0[4 * q + 3]);
              lds_fadd(ir + j, a); if (j + 1 < 64) lds_fadd(ir + j + 1, p0[4 * q + 3]); }
            { const int j = 16 * kt + 8 + 2 * q + hi; const float a = (p1[4 * q] + p1[4 * q + 1]) + (p1[4 * q + 2] + p1[4 * q + 3]);
              lds_fadd(ir + j, a); if (j + 1 < 64) lds_fadd(ir + j + 1, p1[4 * q + 3]); }
        }
        at_pv<64>(st.o, p0, p1, (const LAS char*)lds + AT_V + kt * 8192, lane, hi);
    }
    __syncthreads();
    {
        const int tid2 = (F.wave << 6) | lane_now();
        const int tk = tid2 >> 3, sub = tid2 & 7;
        LAS float* ir = imp + tk * 65;
        const int cur = tb;
        unsigned mybits_lo = 0u, mybits_hi = 0u;
        unsigned long long vals[8];
#pragma unroll
        for (int q = 0; q < 8; ++q) { const int j = sub * 8 + q; const float v = ir[j]; const float vq = (j == 0 || j == cur || j == cur - 1) ? 1e6f : v;
            vals[q] = (j > cur) ? 0ull : (((unsigned long long)__float_as_uint(vq) << 6) | (unsigned long long)(63 - j)); }
        int rank[8];
#pragma unroll
        for (int q = 0; q < 8; ++q) rank[q] = 0;
        for (int jj = 0; jj <= cur; ++jj) { const float v = ir[jj]; const float vv = (jj == 0 || jj == cur || jj == cur - 1) ? 1e6f : v;
            const unsigned long long kj = ((unsigned long long)__float_as_uint(vv) << 6) | (unsigned long long)(63 - jj);
#pragma unroll
            for (int q = 0; q < 8; ++q) rank[q] += (kj > vals[q]) ? 1 : 0; }
#pragma unroll
        for (int q = 0; q < 8; ++q) { const int j = sub * 8 + q; if (rank[q] < 16 && j <= cur) { if (j < 32) mybits_lo |= 1u << j; else mybits_hi |= 1u << (j - 32); } }
        if (mybits_lo) { lds_or(&msk[tk * 2], mybits_lo); lds_or(&msk[128], mybits_lo); }
        if (mybits_hi) { lds_or(&msk[tk * 2 + 1], mybits_hi); lds_or(&msk[129], mybits_hi); }
    }
    __syncthreads();
    at_accum_lds(st.o, nullptr, g0, true, accb, wsf, r32, hi);
    {
        if (tid < 64) { unsigned long long un = ((unsigned long long)msk[129] << 32) | msk[128]; un &= (tb >= 63) ? ~0ull : ((1ull << (tb + 1)) - 1ull);
            if ((un >> tid) & 1ull) tl[__popcll(un >> tid) - 1] = tid;
            if (tid == 0) tl[65] = __popcll(un); }
        __syncthreads();
        const int ntile = __builtin_amdgcn_readfirstlane(tl[65]);
        const int tokl2 = opq(tokl);
        const unsigned long long bits = ((unsigned long long)msk[tokl2 * 2 + 1] << 32) | msk[tokl2 * 2];
        const float sl2 = __builtin_amdgcn_exp2f(-(float)(head + 1)) * LOG2E;
        const bf16* Kg = HM + (size_t)(b * NHM + 8 + g) * SEQ * 64; const bf16* Vg = HM + (size_t)(b * NHM + 10 + g) * SEQ * 64;
        at_std_pass<64>(st, lds, Kg, Vg, 64, tl, ntile, t, bits, 1 << 30, sl2, wid, lane);
        at_accum_lds(st.o, &st.ls, g1, false, accb, wsf, r32, hi);
        __syncthreads();
        if (tid == 0) { int n = 0; for (int j = tb; j >= 0 && j >= tb - 8; --j) tl[n++] = j; tl[65] = n; }
        __syncthreads();
        const int ntw = __builtin_amdgcn_readfirstlane(tl[65]);
        const bf16* Kw = HM + (size_t)(b * NHM + 12 + g) * SEQ * 64; const bf16* Vw = HM + (size_t)(b * NHM + 14 + g) * SEQ * 64;
        at_std_pass<64>(st, lds, Kw, Vw, 64, tl, ntw, t, ~0ull, 512, sl2, wid, lane);
        at_accum_lds(st.o, &st.ls, g2, false, accb, wsf, r32, hi);
    }
    { bf16* yb = YA + ((size_t)b * SEQ + tb * 64 + (wid & 1) * 32) * 1536 + head * 64; const int lane3 = lane_now();
#pragma unroll
      for (int i = 0; i < 4; ++i) { const int row = i * 8 + (lane3 >> 3), ch = lane3 & 7; const f32x4 a = *(const LAS f32x4*)(accb + row * 64 + ch * 8), c = *(const LAS f32x4*)(accb + row * 64 + ch * 8 + 4);
          v4u w; w.x = cvt_pk_bf16(a[0], a[1]); w.y = cvt_pk_bf16(a[2], a[3]); w.z = cvt_pk_bf16(c[0], c[1]); w.w = cvt_pk_bf16(c[2], c[3]); *(v4u*)(yb + (size_t)row * 1536 + ch * 8) = w; }
      LDS_WAIT(); }
    __syncthreads();
}
__device__ __forceinline__ void moba_unit(Frame& F, int b, int h, int ib, const bf16* HM, const float* KMEAN, bf16* YB) {
    LAS unsigned char* lds = F.lds; const int tid = (F.wave << 6) | lane_now(); const int wid = F.wave, lane = tid & 63, r32 = lane & 31, hi = lane >> 5;
    LAS float* wsf = (LAS float*)(lds + AT_WS) + wid * 64;
    LAS unsigned* msk = (LAS unsigned*)(lds + AT_MASK);
    LAS int* tl = (LAS int*)(lds + AT_TL);
    LAS float* km = (LAS float*)(lds + AT_KM);
    const bf16* Qh = HM + (size_t)(b * NHM + 16 + h) * SEQ * 64;
    for (int i = tid; i < 16 * 64; i += 512) km[i] = KMEAN[(size_t)(b * 8 + h) * 1024 + i];
    if (tid == 0) msk[256] = 0u;
    __syncthreads();
    { const int tok = tid & 255, half = F.wave >> 2; const bf16* qp = Qh + (size_t)(ib * 256 + tok) * 64;
      float g8[8];
#pragma unroll
      for (int jj = 0; jj < 8; ++jj) g8[jj] = 0.f;
      if (half * 8 < ib) {
        for (int c = 0; c < 8; ++c) { const v4u qw = *(const v4u*)(qp + c * 8);
            float q[8]; q[0] = bflo(qw.x); q[1] = bfhi(qw.x); q[2] = bflo(qw.y); q[3] = bfhi(qw.y); q[4] = bflo(qw.z); q[5] = bfhi(qw.z); q[6] = bflo(qw.w); q[7] = bfhi(qw.w);
#pragma unroll
            for (int jj = 0; jj < 8; ++jj) { const int j = half * 8 + jj; if (j < ib) {
#pragma unroll
                for (int e = 0; e < 8; ++e) g8[jj] += q[e] * km[j * 64 + c * 8 + e]; } } } }
      LAS float* gx = (LAS float*)(lds + AT_OST);
#pragma unroll
      for (int jj = 0; jj < 8; ++jj) gx[tok * 17 + half * 8 + jj] = g8[jj]; }
    __syncthreads();
    if (tid < 256) {
        float gate[16]; { const LAS float* gx = (const LAS float*)(lds + AT_OST);
#pragma unroll
          for (int j = 0; j < 16; ++j) gate[j] = gx[tid * 17 + j]; }
        unsigned sel = 0u; const int ntop = ib < 3 ? ib : 3;
        for (int k = 0; k < ntop; ++k) { float best = -INFINITY; int bj = 0;
#pragma unroll
            for (int j = 0; j < 16; ++j) { const bool ok = (j < ib) && !((sel >> j) & 1u); if (ok && gate[j] > best) { best = gate[j]; bj = j; } }
            sel |= 1u << bj; }
        msk[tid] = sel; if (sel) lds_or(&msk[256], sel);
    }
    __syncthreads();
    if (tid < 64) { const unsigned un = (msk[256] | (1u << ib)) & ((2u << ib) - 1u); const int kb = tid >> 2;
        if ((un >> kb) & 1u) tl[4 * (__popc(un >> kb) - 1) + (3 - (tid & 3))] = tid;
        if (tid == 0) tl[65] = 4 * __popc(un); }
    __syncthreads();
    const int ntile = __builtin_amdgcn_readfirstlane(tl[65]);
    const int t = ib * 256 + wid * 32 + r32;
    const unsigned selb = msk[wid * 32 + r32] | (1u << ib);
    unsigned xl = selb & 0xFFu, xh = (selb >> 8) & 0xFFu;
    xl = (xl | (xl << 12)) & 0x000F000Fu; xl = (xl | (xl << 6)) & 0x03030303u; xl = (xl | (xl << 3)) & 0x11111111u; xl *= 15u;
    xh = (xh | (xh << 12)) & 0x000F000Fu; xh = (xh | (xh << 6)) & 0x03030303u; xh = (xh | (xh << 3)) & 0x11111111u; xh *= 15u;
    const unsigned long long bits = ((unsigned long long)xh << 32) | xl;
    AttnSt<64> st;
    { const bf16* qp = Qh + (size_t)t * 64;
#pragma unroll
      for (int d0 = 0; d0 < 4; ++d0) st.qr[d0] = *(const bf16x8*)(qp + d0 * 16 + hi * 8); }
    const float sl2 = __builtin_amdgcn_exp2f(-(float)(h + 1)) * LOG2E;
    const bf16* Kg = HM + (size_t)(b * NHM + 24 + h) * SEQ * 64; const bf16* Vg = HM + (size_t)(b * NHM + 32 + h) * SEQ * 64;
    at_std_pass<64, true, true>(st, lds, Kg, Vg, 64, tl, ntile, t, bits, 1 << 30, sl2, wid, lane);
    at_normalize<2>(st.o, st.ls);
    NsaRow rp{YB + ((size_t)b * SEQ + ib * 256 + wid * 32) * 1536 + h * 64, 1536};
    at_write<64>(st.o, lds, wid, lane, rp);
    __syncthreads();
}
__device__ __forceinline__ void xattn_unit(Frame& F, int b, int h, int qb, const bf16* QX, const bf16* KVM, bf16* OX) {
    LAS unsigned char* lds = F.lds; const int tid = (F.wave << 6) | lane_now(); const int wid = F.wave, lane = tid & 63, r32 = lane & 31, hi = lane >> 5;
    LAS float* wsf = (LAS float*)(lds + AT_WS8) + wid * 64;
    const int tg = b * SEQ + qb * 256 + wid * 32 + r32;
    AttnSt<128> st;
    { const bf16* qp = QX + (size_t)tg * 512 + h * 128;
#pragma unroll
      for (int d0 = 0; d0 < 8; ++d0) st.qr[d0] = *(const bf16x8*)(qp + d0 * 16 + hi * 8); }
    const bf16* Kg = KVM + (size_t)b * MEM_LEN * 1024 + h * 128; const bf16* Vg = Kg + 512;
    at_pass_resident128(st, lds, Kg, Vg, 1024, MEM_LEN / 64, wid, lane);
    at_scale_rows<4>(st.o, st.ls, 1.0f / pswap_sum(st.l), wsf, r32, hi);
    NsaRow rp{OX + ((size_t)b * SEQ + qb * 256 + wid * 32) * 512 + h * 128, 512};
    at_write<128>(st.o, lds, wid, lane, rp);
    __syncthreads();
}

struct Args { const float* in[24]; float* out; unsigned char* ws; int ph_lo, ph_hi; };
constexpr int PH_PER_LAYER = 16, PH_TOTAL = 1 + DEPTH * PH_PER_LAYER;

__global__ void __launch_bounds__(NWAVES * 64, 2) mk_fwd(Args args) {
    extern __shared__ __attribute__((aligned(16))) unsigned char lds_raw[];
    LAS unsigned char* const ldsb = (LAS unsigned char*)lds_raw;
    const int wave0 = __builtin_amdgcn_readfirstlane((int)threadIdx.x >> 6);
    const int tid0 = (wave0 << 6) | lane_now();
    volatile LAS unsigned* MISC = (volatile LAS unsigned*)(ldsb + MISC_OFF);
    GAS unsigned char* ws = (GAS unsigned char*)args.ws;
    unsigned* ctl0 = (unsigned*)ws;
    for (int u = tid0; u < (LDS_BYTES - LDSCTL_OFF) / 4; u += NWAVES * 64) ((LAS unsigned*)(ldsb + LDSCTL_OFF))[u] = 0u;
    __syncthreads();
    XcdBarrier bar = xcd_barrier_post(ctl0 + CW_BAR, MISC + 8, tid0 == 0);
    const int lo = args.ph_lo, hi_ph = args.ph_hi;
    int phase = 0;
#ifndef PHMASK
#define PHMASK 0xFFFFFFFFu
#endif
#define PH_BEGIN(id) if (phase >= lo && phase < hi_ph) { if constexpr ((PHMASK >> (id)) & 1u) { Frame F; F.lds = ldsb; F.lane = lane_now(); F.wave = wave0; F.tid = (wave0 << 6) | F.lane; \
      int bx = blockIdx.x, gx = gridDim.x; asm volatile("" : "+s"(bx), "+s"(gx)); F.G = gx; F.vcu = (gx % 8 == 0) ? (bx % 8) * (gx / 8) + bx / 8 : bx; F.gw = F.vcu * NWAVES + F.wave; F.NGW = gx * NWAVES; \
      GAS unsigned char* wsq = ws; asm volatile("" : "+s"(wsq)); GAS unsigned char* const act = wsq + WS_ACT; (void)act; unsigned* const ctl = (unsigned*)wsq; (void)ctl; F.tsw = (unsigned long long*)(ctl + 40000); \
      for (int rep_ = 0; rep_ < ((((REPMASK) >> (id)) & 1u) ? 2 : 1); ++rep_) { if (rep_) __syncthreads();
#define PH_END   } } if (phase + 1 < hi_ph) xcd_barrier(bar, ((wave0 << 6) | lane_now()) == 0); } ++phase;
#define PH_END_G PH_END_GC(true)
#define PH_END_GC(cond_) } } if (phase + 1 < hi_ph) { int bq_ = blockIdx.x, gq_ = gridDim.x; asm volatile("" : "+s"(bq_), "+s"(gq_)); \
      if (gq_ == 256 && (cond_)) { GAS unsigned char* wq_ = ws; asm volatile("" : "+s"(wq_)); grp_barrier((unsigned*)wq_ + CW_BAR, (unsigned*)wq_ + CW_GRP + (bq_ & 7) * 32, 32u, ((wave0 << 6) | lane_now()) == 0); } \
      else xcd_barrier(bar, ((wave0 << 6) | lane_now()) == 0); } } ++phase;

#define GIN(i) ((const float*)(const GAS float*)args.in[i])
#define XIN    GIN(0)
#define MEMIN  GIN(1)
#define HB     ((bf16*)(GAS bf16*)(act + A_HB))
#define HM     ((bf16*)(GAS bf16*)(act + A_HM))
#define CMP    ((bf16*)(GAS bf16*)(act + A_CMP))
#define CONV   ((bf16*)(GAS bf16*)(act + A_CONV))
#define MG     ((bf16*)(GAS bf16*)(act + A_MG))
#define NG     ((float*)(GAS float*)(act + A_NG))
#define H1     ((bf16*)(GAS bf16*)(act + A_H1))
#define CKV    ((bf16*)(GAS bf16*)(act + A_CKV))
#define KMEAN  ((float*)(GAS float*)(act + A_KMEAN))
#define Y3     ((bf16*)(GAS bf16*)(act + A_Y3))
#define MERGED ((bf16*)(GAS bf16*)(act + A_MERGED))
#define DELTAB ((bf16*)(GAS bf16*)(act + A_DELTAB))
#define QX     ((bf16*)(GAS bf16*)(act + A_QX))
#define MEMB   ((bf16*)(GAS bf16*)(act + A_MEMB))
#define KVMall ((bf16*)(GAS bf16*)(act + A_KVM))
#define OX     ((bf16*)(GAS bf16*)(act + A_OX))
#define RS     ((float*)(GAS float*)(act + A_RS))
#define HS     ((bf16*)(GAS bf16*)(act + A_HS))
#define RIDX   ((int*)(GAS int*)(act + A_RIDX))
#define RW     ((float*)(GAS float*)(act + A_RW))
#define RRANK  ((int*)(GAS int*)(act + A_RRANK))
#define RPOS   ((int*)(GAS int*)(act + A_RPOS))
#define ROWTOK ((int*)(GAS int*)(act + A_ROWW))
#define BLKE   ((int*)(GAS int*)(act + A_BLKE))
#define XG     ((bf16*)(GAS bf16*)(act + A_XG))
#define HE     ((bf16*)(GAS bf16*)(act + A_HE))
#define YE     XG
#define KVM    (KVMall + (size_t)l * TM * DM)
#define wl     ((unsigned char*)(wsq + WS_W + (size_t)l * WL_BYTES))
#define wlx(L_) ((unsigned char*)(wsq + WS_W + (size_t)(L_) * WL_BYTES))

    PH_BEGIN(0)
        {
          int off = 0;
#define GWR(n_) ({ int g_ = F.gw - off % F.NGW; if (g_ < 0) g_ += F.NGW; off += (n_); g_; })
          const int l2 = 0;
            cvt_fast(F, GIN(2) + (size_t)l2 * DM * N_IN, N_IN, DM, N_INP, (bf16*)(wlx(l2) + WL_WIN), DM, Map64Win{}, 1, 0, 0, GWR(1920), F.NGW);
            cvt_fast(F, GIN(4) + (size_t)l2 * 2 * 2048 * 256, 256, 2048, 256, (bf16*)(wlx(l2) + WL_W1C), 2048, Map64Ident{}, 2, (size_t)2048 * 256, (size_t)256 * 2048, GWR(256), F.NGW);
            cvt_fast(F, GIN(5) + (size_t)l2 * 2 * 256 * 64, 64, 256, 256, (bf16*)(wlx(l2) + WL_W2C), 256, Map64Pad{64}, 2, (size_t)256 * 64, (size_t)256 * 256, GWR(32), F.NGW);
            cvt_fast(F, GIN(7) + (size_t)l2 * 3 * 512 * 1024, 1024, 512, 1024, (bf16*)(wlx(l2) + WL_WB), 1536, Map64Ident{}, 3, (size_t)512 * 1024, (size_t)512, GWR(384), F.NGW);
            cvt_fast(F, GIN(8) + (size_t)l2 * 1024 * 1024, 1024, 1024, 1024, (bf16*)(wlx(l2) + WL_WOUT), 1024, Map64Ident{}, 1, 0, 0, GWR(256), F.NGW);
            cvt_fast(F, GIN(11) + (size_t)l2 * 1024 * 512, 512, 1024, 512, (bf16*)(wlx(l2) + WL_WQ), 1024, Map64Ident{}, 1, 0, 0, GWR(128), F.NGW);
            cvt_fast(F, GIN(12) + (size_t)l2 * 1024 * 1024, 1024, 1024, 1024, (bf16*)(wlx(l2) + WL_WKV), 1024, Map64Ident{}, 1, 0, 0, GWR(256), F.NGW);
            cvt_fast(F, GIN(13) + (size_t)l2 * 512 * 1024, 1024, 512, 1024, (bf16*)(wlx(l2) + WL_WO), 512, Map64Ident{}, 1, 0, 0, GWR(128), F.NGW);
            cvt_fast(F, GIN(16) + (size_t)l2 * 1024 * 256, 256, 1024, 256, (bf16*)(wlx(l2) + WL_WRS), 1024, Map64Ident{}, 1, 0, 0, GWR(64), F.NGW);
            cvt_fast(F, GIN(20) + (size_t)l2 * 1024 * 512, 512, 1024, 512, (bf16*)(wlx(l2) + WL_WRS) + (size_t)256 * 1024, 1024, Map64AG{256}, 1, 0, 0, GWR(128), F.NGW);
            cvt_fast(F, GIN(21) + (size_t)l2 * 256 * 1024, 1024, 256, 1024, (bf16*)(wlx(l2) + WL_WS2), 256, Map64Ident{}, 1, 0, 0, GWR(64), F.NGW);
#undef GWR
        }
        for (int o = F.gw; o < DEPTH * 2 * 256; o += F.NGW) { const int li = o >> 8, n = o & 255; const float* pe = GIN(3) + (size_t)li * 2048; const float* w1 = GIN(4) + (size_t)li * 2048 * 256;
            float sacc = 0.f; for (int k = F.lane; k < 2048; k += 64) sacc += pe[k] * w1[(size_t)k * 256 + n];
            sacc = wave_sum(sacc, F.lane);
            if (F.lane == 0) ((float*)(wsq + WS_W + (size_t)(li >> 1) * WL_BYTES + WL_CB))[(li & 1) * 256 + n] = sacc; }
        { const size_t n4 = (size_t)T * DM / 4, st = (size_t)F.NGW * 64;
          for (size_t i = (size_t)F.gw * 64 + F.lane; i < n4; i += 4 * st) { f32x4 v[4];
#pragma unroll
              for (int q = 0; q < 4; ++q) if (i + q * st < n4) v[q] = ((const f32x4*)XIN)[i + q * st];
#pragma unroll
              for (int q = 0; q < 4; ++q) if (i + q * st < n4) { v2u w; w.x = cvt_pk_bf16(v[q][0], v[q][1]); w.y = cvt_pk_bf16(v[q][2], v[q][3]); ((v2u*)HB)[i + q * st] = w; } } }
        for (size_t i = (size_t)F.gw * 64 + F.lane; i < (size_t)TM * DM / 4; i += (size_t)F.NGW * 64) { const f32x4 v = ((const f32x4*)MEMIN)[i]; v2u w; w.x = cvt_pk_bf16(v[0], v[1]); w.y = cvt_pk_bf16(v[2], v[3]); ((v2u*)MEMB)[i] = w; }
        if (bx == 1) for (int i = F.tid; i < DM / 2; i += 512) ((unsigned*)(HB + (size_t)T * DM))[i] = 0u;
        if (bx == 0) for (int i = F.tid; i < 2048; i += 512) ((unsigned*)(CMP + (size_t)BATCH * 4 * SEQ * 64))[i] = 0u;
    PH_END

    for (int l = 0; l < DEPTH; ++l) {
        PH_BEGIN(1)
            pg8::Gemm g{HB, (const bf16*)(wl + WL_WIN), DM, DM}; pg8::StaticOrder S; S.init(T, N_INP, F.G, bx);
            EpiWin E{HM, CMP, CONV, MG, NG};
            const int nround = (S.nwg + F.G - 1) / F.G, ksplit = (F.G == 256) ? ((F.vcu >> 5) * nround) / 8 : (int)(((long)F.vcu * nround) / F.G);
            S.i0 = 0; S.imax = ksplit;
            pg8::gemm_phase<EpiWin, pg8::StaticOrder>(F.lds, g, S, E, wave0);
            __syncthreads();
            cvt_fast(F, GIN(18) + (size_t)l * NEXP * 1024 * 512, 512, 1024, 512, (bf16*)(wl + WL_W13), 1024, Map64AG{256}, NEXP, (size_t)1024 * 512, (size_t)512 * 1024, F.gw, F.NGW);
            cvt_fast(F, GIN(19) + (size_t)l * NEXP * 256 * 1024, 1024, 256, 1024, (bf16*)(wl + WL_W2), 256, Map64Ident{}, NEXP, (size_t)256 * 1024, (size_t)1024 * 256, F.gw, F.NGW);
            if (l == 0) {
                int off = 0;
#define GWR(n_) ({ int g_ = F.gw - off % F.NGW; if (g_ < 0) g_ += F.NGW; off += (n_); g_; })
                for (int l2 = 1; l2 < DEPTH; ++l2) {
                cvt_fast(F, GIN(4) + (size_t)l2 * 2 * 2048 * 256, 256, 2048, 256, (bf16*)(wlx(l2) + WL_W1C), 2048, Map64Ident{}, 2, (size_t)2048 * 256, (size_t)256 * 2048, GWR(256), F.NGW);
                cvt_fast(F, GIN(5) + (size_t)l2 * 2 * 256 * 64, 64, 256, 256, (bf16*)(wlx(l2) + WL_W2C), 256, Map64Pad{64}, 2, (size_t)256 * 64, (size_t)256 * 256, GWR(32), F.NGW);
                cvt_fast(F, GIN(7) + (size_t)l2 * 3 * 512 * 1024, 1024, 512, 1024, (bf16*)(wlx(l2) + WL_WB), 1536, Map64Ident{}, 3, (size_t)512 * 1024, (size_t)512, GWR(384), F.NGW);
                cvt_fast(F, GIN(8) + (size_t)l2 * 1024 * 1024, 1024, 1024, 1024, (bf16*)(wlx(l2) + WL_WOUT), 1024, Map64Ident{}, 1, 0, 0, GWR(256), F.NGW);
                cvt_fast(F, GIN(11) + (size_t)l2 * 1024 * 512, 512, 1024, 512, (bf16*)(wlx(l2) + WL_WQ), 1024, Map64Ident{}, 1, 0, 0, GWR(128), F.NGW);
                cvt_fast(F, GIN(12) + (size_t)l2 * 1024 * 1024, 1024, 1024, 1024, (bf16*)(wlx(l2) + WL_WKV), 1024, Map64Ident{}, 1, 0, 0, GWR(256), F.NGW);
                cvt_fast(F, GIN(13) + (size_t)l2 * 512 * 1024, 1024, 512, 1024, (bf16*)(wlx(l2) + WL_WO), 512, Map64Ident{}, 1, 0, 0, GWR(128), F.NGW);
                cvt_fast(F, GIN(16) + (size_t)l2 * 1024 * 256, 256, 1024, 256, (bf16*)(wlx(l2) + WL_WRS), 1024, Map64Ident{}, 1, 0, 0, GWR(64), F.NGW);
                cvt_fast(F, GIN(20) + (size_t)l2 * 1024 * 512, 512, 1024, 512, (bf16*)(wlx(l2) + WL_WRS) + (size_t)256 * 1024, 1024, Map64AG{256}, 1, 0, 0, GWR(128), F.NGW);
                cvt_fast(F, GIN(21) + (size_t)l2 * 256 * 1024, 1024, 256, 1024, (bf16*)(wlx(l2) + WL_WS2), 256, Map64Ident{}, 1, 0, 0, GWR(64), F.NGW);
                }
                cvt_fast(F, GIN(2) + (size_t)1 * DM * N_IN, N_IN, DM, N_INP, (bf16*)(wlx(1) + WL_WIN), DM, Map64Win{}, 1, 0, 0, GWR(1920), F.NGW);
            }
#undef GWR
            __syncthreads();
            S.i0 = ksplit; S.imax = 1 << 30;
            pg8::gemm_phase<EpiWin, pg8::StaticOrder>(F.lds, g, S, E, wave0);
        PH_END_G
        PH_BEGIN(2)
            const bool grp = (F.G == 256); const int gj = F.vcu & 31, gg = F.vcu >> 5;
            const int cmpG = grp ? (1 << 20) : F.G, cmpC = grp ? ((gj < 4) ? 4 * gg + gj : (1 << 20)) : bx;
            { pg8::Gemm g{CMP, (const bf16*)(wl + WL_W1C), 1024, 2048}; SchedCmp S{cmpG, cmpC}; EpiCmp1 E{H1, (const float*)(wl + WL_CB)};
              pg8::gemm_phase<EpiCmp1, SchedCmp>(F.lds, g, S, E, wave0); }
            { pg8::Gemm g{MEMB, (const bf16*)(wl + WL_WKV), DM, DM}; EpiBf16 E{KVM, 1024, 1.0f};
              if (grp) { SchedOpt S{gg, gj - 4, gj >= 4 && gj < 8}; pg8::gemm_phase<EpiBf16, SchedOpt>(F.lds, g, S, E, wave0); }
              else { pg8::StaticOrder S; S.init(TM, 1024, F.G, ((bx + F.G - 32) % F.G)); pg8::gemm_phase<EpiBf16, pg8::StaticOrder>(F.lds, g, S, E, wave0); } }
            asm volatile("s_waitcnt vmcnt(0)" ::: "memory"); __builtin_amdgcn_fence(__ATOMIC_ACQUIRE, "agent"); asm volatile("s_waitcnt vmcnt(0)" ::: "memory"); __syncthreads();
            { pg8::Gemm g{H1, (const bf16*)(wl + WL_W2C), 256, 256}; SchedCmp S{cmpG, cmpC}; EpiCmp2 E{CKV};
              pg8::gemm_phase<EpiCmp2, SchedCmp>(F.lds, g, S, E, wave0); }
            for (int o = grp ? ((gj >= 8 && gj < 24) ? gg * 128 + (gj - 8) * NWAVES + F.wave : BATCH * 8 * 16) : F.gw; o < BATCH * 8 * 16; o += grp ? BATCH * 8 * 16 : F.NGW) { const int b = o >> 7, h = (o >> 4) & 7, blk = o & 15; const bf16* kp = HM + ((size_t)(b * NHM + 24 + h) * SEQ + blk * 256) * 64 + (F.lane >> 3) * 64 + (F.lane & 7) * 8;
                float a8[8];
#pragma unroll
                for (int e = 0; e < 8; ++e) a8[e] = 0.f;
#pragma unroll 8
                for (int i = 0; i < 32; ++i) { const v4u w = *(const v4u*)(kp + (size_t)i * 8 * 64);
                    a8[0] += bflo(w.x); a8[1] += bfhi(w.x); a8[2] += bflo(w.y); a8[3] += bfhi(w.y); a8[4] += bflo(w.z); a8[5] += bfhi(w.z); a8[6] += bflo(w.w); a8[7] += bfhi(w.w); }
#pragma unroll
                for (int e = 0; e < 8; ++e) { float v = a8[e]; v += shx(v, 8, F.lane); v += shx(v, 16, F.lane); v += shx(v, 32, F.lane); a8[e] = v * (1.0f / 256.0f); }
                if (F.lane < 8) { float* dp = KMEAN + (size_t)o * 64 + F.lane * 8; *(f32x4*)dp = (f32x4){a8[0], a8[1], a8[2], a8[3]}; *(f32x4*)(dp + 4) = (f32x4){a8[4], a8[5], a8[6], a8[7]}; } }
            { const float* cw = GIN(6) + (size_t)l * 3 * 512; bf16* YC = Y3 + 1024; const bf16* cv_ = CONV; const int st = NWAVES * 64;
              int o_lo, o_hi;
              if (grp) { constexpr int QN = 1214; const int q0 = (gj < 4) ? gj : (gj < 8) ? 4 + 5 * (gj - 4) : 24 + 8 * (gj - 8), nq = (gj < 4) ? 1 : (gj < 8) ? 5 : 8;
                  const int base = gg * SEQ * 64; o_lo = base + q0 * QN; o_hi = base + (q0 + nq) * QN; if (o_hi > base + SEQ * 64) o_hi = base + SEQ * 64; }
              else { const int per = (T * 64 + F.G - 1) / F.G; o_lo = F.vcu * per; o_hi = o_lo + per; if (o_hi > T * 64) o_hi = T * 64; }
              for (int o = o_lo + F.wave * 64 + F.lane; o < o_hi; o += 2 * st) {
                  v4u hv[2][3], cv[2][3], bv[2]; int tt[2], cc[2]; bool ok[2];
#pragma unroll
                  for (int q = 0; q < 2; ++q) { const int oq = o + q * st; ok[q] = oq < o_hi; const int t = ok[q] ? (oq >> 6) : 0, c0 = (oq & 63) * 8; tt[q] = t; cc[q] = c0; const int sq = t & (SEQ - 1); const int e0 = t * 1536 + c0;
#pragma unroll
                      for (int k = 0; k < 3; ++k) { const int ss = sq - 2 + k; const int er = (ss >= 0) ? e0 + (k - 2) * 1536 : e0; hv[q][k] = *(const v4u*)(cv_ + er); cv[q][k] = *(const v4u*)(cv_ + er + 1024);
                          if (ss < 0) { hv[q][k] = (v4u){0u, 0u, 0u, 0u}; } }
                      bv[q] = *(const v4u*)(cv_ + e0 + 512); }
#pragma unroll
                  for (int q = 0; q < 2; ++q) { if (!ok[q]) continue; float acc[8];
#pragma unroll
                      for (int e = 0; e < 8; ++e) acc[e] = 0.f;
#pragma unroll
                      for (int k = 0; k < 3; ++k) { const float* wk = cw + k * 512 + cc[q]; const v4u h = hv[q][k], c = cv[q][k];
                          acc[0] += wk[0] * bflo(h.x) * bflo(c.x); acc[1] += wk[1] * bfhi(h.x) * bfhi(c.x); acc[2] += wk[2] * bflo(h.y) * bflo(c.y); acc[3] += wk[3] * bfhi(h.y) * bfhi(c.y);
                          acc[4] += wk[4] * bflo(h.z) * bflo(c.z); acc[5] += wk[5] * bfhi(h.z) * bfhi(c.z); acc[6] += wk[6] * bflo(h.w) * bflo(c.w); acc[7] += wk[7] * bfhi(h.w) * bfhi(c.w); }
                      const v4u b = bv[q];
                      v4u w; w.x = cvt_pk_bf16(acc[0] * bflo(b.x), acc[1] * bfhi(b.x)); w.y = cvt_pk_bf16(acc[2] * bflo(b.y), acc[3] * bfhi(b.y)); w.z = cvt_pk_bf16(acc[4] * bflo(b.z), acc[5] * bfhi(b.z)); w.w = cvt_pk_bf16(acc[6] * bflo(b.w), acc[7] * bfhi(b.w));
                      *(v4u*)(YC + (size_t)tt[q] * 1536 + cc[q]) = w; } } }
        PH_END_G
        PH_BEGIN(18)
            { bf16* YB = Y3 + 512;
              if (F.G == 256) { const int bh = F.vcu >> 2, s4 = F.vcu & 3;
                  for (int i = 0; i < 4; ++i) { const int ib = (i == 0) ? s4 : (i == 1) ? 7 - s4 : (i == 2) ? 8 + s4 : 15 - s4; moba_unit(F, bh >> 3, bh & 7, ib, HM, KMEAN, YB); } }
              else for (int u = F.vcu; u < 1024; u += F.G) moba_unit(F, u >> 7, (u >> 4) & 7, u & 15, HM, KMEAN, YB); }
            __syncthreads();
            { bf16* YA = Y3;
              if (F.G == 256) { const int bg = F.vcu >> 4, s16 = F.vcu & 15;
                  for (int i = 0; i < 4; ++i) { const int tb = (i == 0) ? s16 : (i == 1) ? 31 - s16 : (i == 2) ? 32 + s16 : 63 - s16; nsa_unit(F, bg >> 1, bg & 1, tb, HM, CKV, NG, YA); } }
              else for (int u = F.vcu; u < 1024; u += F.G) nsa_unit(F, u >> 7, (u >> 6) & 1, u & 63, HM, CKV, NG, YA); }
        PH_END_G
        PH_BEGIN(5)
            pg8::Gemm g{Y3, (const bf16*)(wl + WL_WB), 1536, 1536}; pg8::StaticOrder S; S.init(T, DM, F.G, bx); EpiMergeK E{MG, MERGED};
            pg8::gemm_phase<EpiMergeK, pg8::StaticOrder>(F.lds, g, S, E, wave0);
        PH_END_G
        PH_BEGIN(6)
            pg8::Gemm g{MERGED, (const bf16*)(wl + WL_WOUT), DM, DM}; pg8::StaticOrder S; S.init(T, DM, F.G, bx); EpiBf16 E{DELTAB, DM, 1.0f};
            pg8::gemm_phase<EpiBf16, pg8::StaticOrder>(F.lds, g, S, E, wave0);
        PH_END_G
        PH_BEGIN(7)
            ln_phase<false>(F, HB, DELTAB, nullptr, nullptr, nullptr, GIN(9) + (size_t)l * DM, GIN(10) + (size_t)l * DM, nullptr, HB);
        PH_END_G
        PH_BEGIN(8)
            pg8::Gemm g{HB, (const bf16*)(wl + WL_WQ), DM, DM}; pg8::StaticOrder S; S.init(T, 512, F.G, bx); EpiBf16 E{QX, 512, QSC128};
            pg8::gemm_phase<EpiBf16, pg8::StaticOrder>(F.lds, g, S, E, wave0);
        PH_END_G
        PH_BEGIN(9)
            if (F.G == 256) { for (int k = 0; k < 2; ++k) { const int uu = (F.vcu & 31) + 32 * k; xattn_unit(F, F.vcu >> 5, uu >> 4, uu & 15, QX, KVM, OX); } }
            else for (int u = F.vcu; u < BATCH * 4 * 16; u += F.G) xattn_unit(F, u >> 6, (u >> 4) & 3, u & 15, QX, KVM, OX);
        PH_END_G
        PH_BEGIN(10)
            pg8::Gemm g{OX, (const bf16*)(wl + WL_WO), 512, 512}; pg8::StaticOrder S; S.init(T, DM, F.G, bx); EpiBf16 E{DELTAB, DM, 1.0f};
            pg8::gemm_phase<EpiBf16, pg8::StaticOrder>(F.lds, g, S, E, wave0);
        PH_END_G
        PH_BEGIN(11)
            ln_phase<false>(F, HB, DELTAB, nullptr, nullptr, nullptr, GIN(14) + (size_t)l * DM, GIN(15) + (size_t)l * DM, nullptr, HB);
        PH_END_G
        PH_BEGIN(12)
            pg8::Gemm g{HB, (const bf16*)(wl + WL_WRS), DM, DM}; pg8::StaticOrder S; S.init(T, 768, F.G, bx); EpiRS E{RS, HS};
            pg8::gemm_phase<EpiRS, pg8::StaticOrder>(F.lds, g, S, E, wave0);
        PH_END_G
        PH_BEGIN(13)
            { pg8::Gemm g{HS, (const bf16*)(wl + WL_WS2), 256, 256}; pg8::StaticOrder S; S.init(T, DM, F.G, bx); EpiBf16 E{DELTAB, DM, 1.0f};
              pg8::gemm_phase<EpiBf16, pg8::StaticOrder>(F.lds, g, S, E, wave0); }
            const float* rb = GIN(17) + (size_t)l * NEXP; unsigned* cnt = ctl + CW_CNT + l * NEXP;
            const int lane = F.lane;
            const f32x4 rbv = *(const f32x4*)(rb + lane * 4);
            const bool grp = (F.G == 256);
            for (int t = grp ? (F.vcu >> 5) * SEQ + (F.vcu & 31) * NWAVES + F.wave : F.gw; t < (grp ? ((F.vcu >> 5) + 1) * SEQ : T); t += grp ? 32 * NWAVES : F.NGW) {
                const f32x4 lg = *(const f32x4*)(RS + (size_t)t * 256 + lane * 4);
                float s[4], sb[4];
#pragma unroll
                for (int j = 0; j < 4; ++j) { s[j] = sigmoidf_(lg[j]); sb[j] = s[j] + rbv[j]; }
                float m1 = fmaxf(sb[0], sb[1]), m2 = fminf(sb[0], sb[1]);
                { const float a = fmaxf(sb[2], sb[3]), c = fminf(sb[2], sb[3]); const float n1 = fmaxf(m1, a), n2 = fmaxf(fminf(m1, a), fmaxf(m2, c)); m1 = n1; m2 = n2; }
#pragma unroll
                for (int o = 1; o < 8; o <<= 1) { const float a1 = shx(m1, o, lane), a2 = shx(m2, o, lane); const float n1 = fmaxf(m1, a1), n2 = fmaxf(fminf(m1, a1), fmaxf(m2, a2)); m1 = n1; m2 = n2; }
                const float gs = m1 + m2; const int mygrp = lane >> 3;
                int grank = 0;
#pragma unroll
                for (int gq = 0; gq < 8; ++gq) { const float og = shf(gs, gq * 8); grank += (og > gs || (og == gs && gq < mygrp)) ? 1 : 0; }
                const bool gsel = grank < 4;
                float cand[4];
#pragma unroll
                for (int j = 0; j < 4; ++j) cand[j] = gsel ? sb[j] : -1e30f;
                unsigned key[4];
#pragma unroll
                for (int j = 0; j < 4; ++j) { const unsigned u = __float_as_uint(cand[j]); key[j] = gsel ? ((u & 0x80000000u) ? ~u : (u | 0x80000000u)) : 0u; }
                unsigned Tk = 0u;
                for (int bit = 31; bit >= 0; --bit) { const unsigned trial = Tk | (1u << bit);
                    const int cnt = __popcll(__ballot(key[0] >= trial)) + __popcll(__ballot(key[1] >= trial)) + __popcll(__ballot(key[2] >= trial)) + __popcll(__ballot(key[3] >= trial));
                    if (cnt >= TOPK) Tk = trial; }
                int ngt = 0, tie_lo = 0, mytie[4], mysel[4];
#pragma unroll
                for (int j = 0; j < 4; ++j) { const unsigned long long bg = __ballot(key[j] > Tk), be = __ballot(key[j] == Tk); ngt += __popcll(bg);
                    tie_lo += __builtin_amdgcn_mbcnt_hi((unsigned)(be >> 32), __builtin_amdgcn_mbcnt_lo((unsigned)be, 0)); mytie[j] = (key[j] == Tk) ? 1 : 0; }
                const int need = TOPK - ngt;
                { int t_before = tie_lo;
#pragma unroll
                  for (int j = 0; j < 4; ++j) { mysel[j] = (key[j] > Tk) ? 1 : ((mytie[j] && t_before < need) ? 1 : 0); t_before += mytie[j]; } }
                int slot = 0;
#pragma unroll
                for (int j = 0; j < 4; ++j) { const unsigned long long bs = __ballot(mysel[j] != 0); slot += __builtin_amdgcn_mbcnt_hi((unsigned)(bs >> 32), __builtin_amdgcn_mbcnt_lo((unsigned)bs, 0)); }
                LAS float* cv = (LAS float*)F.lds + F.wave * 512;
#pragma unroll
                for (int j = 0; j < 4; ++j) { if (mysel[j]) { ((LAS int*)cv)[256 + slot] = lane * 4 + j; cv[264 + slot] = s[j]; } slot += mysel[j]; }
                LDS_WAIT();
                int myidx = 0; float myw = 0.f;
                if (lane < TOPK) { myidx = ((LAS int*)cv)[256 + lane]; myw = cv[264 + lane]; }
                LDS_WAIT();
                float wsum = (lane < TOPK) ? myw : 0.f;
#pragma unroll
                for (int o = 1; o < 8; o <<= 1) wsum += shx(wsum, o, lane);
                if (lane < TOPK) { const float w = myw / wsum * 2.5f; const unsigned rk = atomicAdd(&cnt[myidx], 1u);
                    RIDX[(size_t)t * 8 + lane] = myidx; RW[(size_t)t * 8 + lane] = w; RRANK[(size_t)t * 8 + lane] = (int)rk; }
            }
        PH_END
        PH_BEGIN(14)
            LAS int* pst = (LAS int*)F.lds; unsigned* cnt = ctl + CW_CNT + l * NEXP;
            if (F.tid < NEXP) pst[256 + F.tid] = (int)((__hip_atomic_load(&cnt[F.tid], __ATOMIC_RELAXED, __HIP_MEMORY_SCOPE_AGENT) + 255u) >> 8);
            __syncthreads();
            { const int nbv = (F.tid < NEXP) ? pst[256 + F.tid] : 0; int inc = nbv;
#pragma unroll
              for (int o = 1; o < 64; o <<= 1) { const int up = __builtin_amdgcn_ds_bpermute(((F.lane - o) & 63) << 2, inc); if (F.lane >= o) inc += up; }
              if (F.tid < NEXP && F.lane == 63) pst[520 + F.wave] = inc;
              __syncthreads();
              if (F.tid < NEXP) { int base = 0; for (int w = 0; w < F.wave; ++w) base += pst[520 + w]; pst[F.tid] = base + inc - nbv; if (F.tid == NEXP - 1) pst[512] = base + inc; } }
            __syncthreads();
            if (bx == 0) { for (int e = F.tid; e < NEXP; e += 512) { const int b0 = pst[e], nb = pst[256 + e]; const int c = (int)__hip_atomic_load(&cnt[e], __ATOMIC_RELAXED, __HIP_MEMORY_SCOPE_AGENT);
                for (int q = 0; q < nb; ++q) { const int nr = (c - q * 256 < 256) ? c - q * 256 : 256; BLKE[b0 + q] = e | (nr << 16); } }
                if (F.tid == 0) BLKE[NBLK_MAX] = pst[512]; }
            for (int a = F.gw * 64 + F.lane; a < T * TOPK; a += F.NGW * 64) { const int e = RIDX[a], rk = RRANK[a]; const int dest = pst[e] * 256 + rk; ROWTOK[dest] = a >> 3; RPOS[a] = dest; }
            for (int e = F.vcu; e < NEXP; e += F.G) { const int c = (int)__hip_atomic_load(&cnt[e], __ATOMIC_RELAXED, __HIP_MEMORY_SCOPE_AGENT); const int r0 = pst[e] * 256 + c, r1 = (pst[e] + pst[256 + e]) * 256;
                for (int r = r0 + F.tid; r < r1; r += NWAVES * 64) ROWTOK[r] = T; }
            __syncthreads();
        PH_END
        PH_BEGIN(15)
            LAS int* bt = (LAS int*)(F.lds + LDSCTL_OFF + 1024);
            for (int i = F.tid; i <= NBLK_MAX; i += NWAVES * 64) bt[i] = BLKE[i];
            __syncthreads();
            const int NBq = __builtin_amdgcn_readfirstlane(bt[NBLK_MAX]);
            pg8::Gemm g{HB, (const bf16*)(wl + WL_W13), DM, DM, ROWTOK}; SchedGrouped S{F.G, F.vcu, 2, NBq, bt}; EpiE1 E{HE};
            pg8::gemm_phase<EpiE1, SchedGrouped, true, true, true>(F.lds, g, S, E, wave0);
        PH_END
        PH_BEGIN(16)
            LAS int* bt = (LAS int*)(F.lds + LDSCTL_OFF + 1024);
            for (int i = F.tid; i <= NBLK_MAX; i += NWAVES * 64) bt[i] = BLKE[i];
            __syncthreads();
            const int NBq = __builtin_amdgcn_readfirstlane(bt[NBLK_MAX]);
            { pg8::Gemm g{HE, (const bf16*)(wl + WL_W2), 256, 256}; SchedGrouped S{F.G, F.vcu, 4, NBq, bt}; EpiE2 E{YE};
              pg8::gemm_phase<EpiE2, SchedGrouped>(F.lds, g, S, E, wave0); }
        PH_END

        PH_BEGIN(17)
            float* outf = (l == DEPTH - 1) ? (float*)(GAS float*)args.out : nullptr;
            const float dsc = 1.0f;
            ln_phase<true>(F, HB, DELTAB, YE, RPOS, RW, GIN(22) + (size_t)l * DM, GIN(23) + (size_t)l * DM, outf, (l == DEPTH - 1) ? nullptr : HB, dsc);
        PH_END_G
    }
#undef PH_BEGIN
#undef PH_END
#undef PH_END_G
#undef PH_END_GC
}

extern "C" void kernel_launch(void* const* d_in, const int* in_sizes, int n_in, void* d_out, int out_size, void* d_ws, size_t ws_size, hipStream_t stream) {
    static int grid = 0;
    if (grid == 0) {
        if (n_in != 24 || ws_size < WS_END) { fprintf(stderr, "kernel_launch: need 24 inputs and %zu bytes of workspace (got %d, %zu)\n", (size_t)WS_END, n_in, ws_size); grid = -1; return; }
        int dev = 0, cus = 0, per_cu = 0;
        if (hipGetDevice(&dev) != hipSuccess || hipDeviceGetAttribute(&cus, hipDeviceAttributeMultiprocessorCount, dev) != hipSuccess) { grid = -1; return; }
        if (hipFuncSetAttribute((const void*)mk_fwd, hipFuncAttributeMaxDynamicSharedMemorySize, LDS_BYTES) != hipSuccess) { fprintf(stderr, "kernel_launch: hipFuncSetAttribute failed\n"); grid = -1; return; }
        if (hipOccupancyMaxActiveBlocksPerMultiprocessor(&per_cu, (const void*)mk_fwd, NWAVES * 64, LDS_BYTES) != hipSuccess || per_cu < 1) { fprintf(stderr, "kernel_launch: occupancy query says %d\n", per_cu); }
        (void)hipGetLastError();
        grid = cus;
    }
    if (grid < 0) return;
    (void)hipMemsetAsync(d_ws, 0, CTL_BYTES, stream);
    Args a{};
    for (int i = 0; i < 24; ++i) a.in[i] = (const float*)d_in[i];
    a.out = (float*)d_out; a.ws = (unsigned char*)d_ws;
#ifndef MK_CUTS
    a.ph_lo = 0; a.ph_hi = PH_TOTAL;
    hipLaunchKernelGGL(mk_fwd, dim3(grid), dim3(NWAVES * 64), LDS_BYTES, stream, a);
#else
    for (int p = 0; p < PH_TOTAL; ++p) { a.ph_lo = p; a.ph_hi = p + 1; hipLaunchKernelGGL(mk_fwd, dim3(grid), dim3(NWAVES * 64), LDS_BYTES, stream, a); }
#endif
}
```
